# Optimizing an MI355X kernel written in HIP

```python
import jax, jax.numpy as jnp
from jax import lax
import numpy as np

D_MODEL = 1024
BATCH = 8
SEQ = 2048
DEPTH = 1

D_MIX = D_MODEL
HG_HEADS = 4
HG_KEY = 128
HG_VAL = 128
HG_FDIM = HG_HEADS * HG_KEY
HG_VDIM = HG_HEADS * HG_VAL
HG_CHUNK = 64
MLA_HEADS = 4
MLA_Q_RANK = 384
MLA_KV_RANK = 128
MLA_NOPE = 128
MLA_ROPE = 64
MLA_VHEAD = 128
MLA_VDIM = MLA_HEADS * MLA_VHEAD
ROPE_THETA = 10000.0
Q_BLOCK = 128
IN_COLS = 3 * HG_FDIM + 2 * HG_VDIM + MLA_Q_RANK + MLA_KV_RANK + MLA_ROPE
D_FF = 2816
CONV_W = 3
DN_ALPHA = (2.0 * DEPTH) ** 0.25
DN_BETA = (8.0 * DEPTH) ** -0.25
NORM_EPS = 1e-5

kernel_name = "hymba_hgrn2_mla_convglu_deepnorm_encoder"


def _layernorm(x, g, b):
    xf = x.astype(jnp.float32)
    mu = jnp.mean(xf, -1, keepdims=True)
    var = jnp.mean(jnp.square(xf - mu), -1, keepdims=True)
    return ((xf - mu) * lax.rsqrt(var + NORM_EPS) * g + b).astype(x.dtype)


def _rmsnorm(x, g):
    xf = x.astype(jnp.float32)
    y = xf * lax.rsqrt(jnp.mean(xf * xf, -1, keepdims=True) + NORM_EPS)
    return (y * g).astype(x.dtype)


def _rope(x, cos, sin):
    half = MLA_ROPE // 2
    xf = x.astype(jnp.float32)
    x1, x2 = xf[..., :half], xf[..., half:]
    return jnp.concatenate([x1 * cos - x2 * sin, x2 * cos + x1 * sin], -1).astype(x.dtype)


def _gla_chunk_scan(q, k, v, g):
    B, H, S, K = q.shape
    V = v.shape[-1]
    n = S // HG_CHUNK

    def to_chunks(t):
        return t.astype(jnp.float32).reshape(B, H, n, HG_CHUNK, t.shape[-1]).transpose(2, 0, 1, 3, 4)

    qc, kc, vc, gc = to_chunks(q), to_chunks(k), to_chunks(v), to_chunks(g)
    mask = jnp.tril(jnp.ones((HG_CHUNK, HG_CHUNK), dtype=bool))[:, :, None]

    def step(state, inp):
        qb, kb, vb, gb = inp
        G = jnp.cumsum(gb, axis=2)
        o_inter = jnp.einsum('bhck,bhkv->bhcv', qb * jnp.exp(G), state)
        diff = G[:, :, :, None, :] - G[:, :, None, :, :]
        decay = jnp.exp(jnp.where(mask, diff, -jnp.inf))
        A = jnp.einsum('bhtk,bhsk,bhtsk->bhts', qb, kb, decay)
        o = o_inter + jnp.einsum('bhts,bhsv->bhtv', A, vb)
        G_last = G[:, :, -1:, :]
        new_state = jnp.exp(G_last[:, :, 0, :])[..., None] * state + jnp.einsum(
            'bhck,bhcv->bhkv', kb * jnp.exp(G_last - G), vb)
        return new_state, o

    s0 = jnp.zeros((B, H, K, V), jnp.float32)
    _, o = lax.scan(step, s0, (qc, kc, vc, gc))
    return o.transpose(1, 2, 0, 3, 4).reshape(B, H, S, V)


def _hgrn2_group(q_raw, i_raw, ff_raw, fb_raw, g_raw, lb_f, lb_b, norm_g):
    B, S, _ = q_raw.shape

    def heads(t, d):
        return t.reshape(B, S, HG_HEADS, d).transpose(0, 2, 1, 3)

    q = heads(jax.nn.silu(q_raw.astype(jnp.float32)), HG_KEY)
    v = heads(i_raw.astype(jnp.float32), HG_VAL)

    def gates(f_raw, lb):
        f = lb + (1.0 - lb) * jax.nn.sigmoid(f_raw.astype(jnp.float32))
        return heads(1.0 - f, HG_KEY), heads(jnp.log(f), HG_KEY)

    k_f, g_f = gates(ff_raw, lb_f)
    k_b, g_b = gates(fb_raw, lb_b)
    o_f = _gla_chunk_scan(q, k_f, v, g_f)
    flip = lambda t: jnp.flip(t, axis=2)
    o_b = flip(_gla_chunk_scan(flip(q), flip(k_b), flip(v), flip(g_b)))
    o = (o_f + o_b).transpose(0, 2, 1, 3)
    gate = g_raw.astype(jnp.float32).reshape(B, S, HG_HEADS, HG_VAL)
    o = _rmsnorm(o, norm_g) * jax.nn.silu(gate)
    return o.reshape(B, S, HG_VDIM).astype(q_raw.dtype)


def _block_attention(q_nope, q_pe, k_nope, k_pe, v):
    B, H, S, N = q_nope.shape
    nb = S // Q_BLOCK
    scale = (MLA_NOPE + MLA_ROPE) ** -0.5

    def blocks(t):
        return t.reshape(B, H, nb, Q_BLOCK, t.shape[-1]).transpose(2, 0, 1, 3, 4)

    def one(blk):
        qn, qr = blk
        s = (jnp.einsum('bhqn,bhkn->bhqk', qn, k_nope)
             + jnp.einsum('bhqr,bkr->bhqk', qr, k_pe)).astype(jnp.float32) * scale
        p = jax.nn.softmax(s, axis=-1)
        return jnp.einsum('bhqk,bhkd->bhqd', p.astype(v.dtype), v)

    o = lax.map(one, (blocks(q_nope), blocks(q_pe)))
    return o.transpose(1, 2, 0, 3, 4).reshape(B, H, S, v.shape[-1])


def _mla_group(qa, kva, kr, cos, sin, q_a_norm_g, w_q_b, kv_a_norm_g, w_kv_b, attn_norm_g):
    B, S, _ = qa.shape
    qh = (_rmsnorm(qa, q_a_norm_g) @ w_q_b).reshape(B, S, MLA_HEADS, MLA_NOPE + MLA_ROPE)
    q_nope = qh[..., :MLA_NOPE]
    q_pe = _rope(qh[..., MLA_NOPE:], cos[:, :, None, :], sin[:, :, None, :])
    kvh = (_rmsnorm(kva, kv_a_norm_g) @ w_kv_b).reshape(B, S, MLA_HEADS, MLA_NOPE + MLA_VHEAD)
    k_nope, v = kvh[..., :MLA_NOPE], kvh[..., MLA_NOPE:]
    k_pe = _rope(kr, cos, sin)
    t = lambda a: a.transpose(0, 2, 1, 3)
    o = _block_attention(t(q_nope), t(q_pe), t(k_nope), k_pe, t(v))
    o = _rmsnorm(t(o), attn_norm_g)
    return o.reshape(B, S, MLA_VDIM)


def _conv_glu_ffn(h, w_up, conv_w, conv_b, w_down):
    u = h @ w_up
    up = jnp.pad(u, ((0, 0), (1, 1), (0, 0)))
    c = up[:, :-2] * conv_w[0] + up[:, 1:-1] * conv_w[1] + up[:, 2:] * conv_w[2] + conv_b
    a, b = c[..., :D_FF], c[..., D_FF:]
    return (jax.nn.gelu(a) * b) @ w_down


def setup_inputs(seed: int = 0) -> dict:
    key = jax.random.key(seed)
    ks = jax.random.split(key, 24)
    f32 = jnp.float32
    nrm = lambda k, shape, s: jax.random.normal(k, shape, f32) * s
    gain = lambda k, shape: 1.0 + 0.02 * jax.random.normal(k, shape, f32)
    return {
        "x": jax.random.normal(ks[0], (BATCH, SEQ, D_MODEL), f32),
        "positions": jnp.broadcast_to(jnp.arange(SEQ, dtype=jnp.int32), (BATCH, SEQ)),
        "ln_in_g": gain(ks[1], (D_MODEL,)),
        "ln_in_b": nrm(ks[2], (D_MODEL,), 0.02),
        "w_in": nrm(ks[3], (DEPTH, D_MODEL, IN_COLS), D_MODEL ** -0.5),
        "lb_fwd": nrm(ks[4], (DEPTH + 1, HG_FDIM), 0.1),
        "lb_bwd": nrm(ks[5], (DEPTH + 1, HG_FDIM), 0.1),
        "hg_norm_g": gain(ks[6], (DEPTH, HG_VAL)),
        "q_a_norm_g": gain(ks[7], (DEPTH, MLA_Q_RANK)),
        "w_q_b": nrm(ks[8], (DEPTH, MLA_Q_RANK, MLA_HEADS * (MLA_NOPE + MLA_ROPE)), MLA_Q_RANK ** -0.5),
        "kv_a_norm_g": gain(ks[9], (DEPTH, MLA_KV_RANK)),
        "w_kv_b": nrm(ks[10], (DEPTH, MLA_KV_RANK, MLA_HEADS * (MLA_NOPE + MLA_VHEAD)), MLA_KV_RANK ** -0.5),
        "attn_norm_g": gain(ks[11], (DEPTH, MLA_VHEAD)),
        "w_out": nrm(ks[12], (DEPTH, D_MIX, D_MODEL), DN_BETA * D_MIX ** -0.5),
        "ln1_g": gain(ks[13], (DEPTH, D_MODEL)),
        "ln1_b": nrm(ks[14], (DEPTH, D_MODEL), 0.02),
        "w_up": nrm(ks[15], (DEPTH, D_MODEL, 2 * D_FF), D_MODEL ** -0.5),
        "conv_w": nrm(ks[16], (DEPTH, CONV_W, 2 * D_FF), CONV_W ** -0.5),
        "conv_b": nrm(ks[17], (DEPTH, 2 * D_FF), 0.02),
        "w_down": nrm(ks[18], (DEPTH, D_FF, D_MODEL), DN_BETA * D_FF ** -0.5),
        "ln2_g": gain(ks[19], (DEPTH, D_MODEL)),
        "ln2_b": nrm(ks[20], (DEPTH, D_MODEL), 0.02),
    }


def reference(x, positions, ln_in_g, ln_in_b, w_in, lb_fwd, lb_bwd, hg_norm_g,
              q_a_norm_g, w_q_b, kv_a_norm_g, w_kv_b, attn_norm_g, w_out, ln1_g, ln1_b,
              w_up, conv_w, conv_b, w_down, ln2_g, ln2_b):
    half = MLA_ROPE // 2
    inv_freq = 1.0 / (ROPE_THETA ** (jnp.arange(half, dtype=jnp.float32) / half))
    ang = positions.astype(jnp.float32)[..., None] * inv_freq
    cos, sin = jnp.cos(ang), jnp.sin(ang)
    lbs_f = jnp.cumsum(jax.nn.softmax(lb_fwd.astype(jnp.float32), axis=0), axis=0)
    lbs_b = jnp.cumsum(jax.nn.softmax(lb_bwd.astype(jnp.float32), axis=0), axis=0)
    split_at = np.cumsum([HG_FDIM, HG_VDIM, HG_FDIM, HG_FDIM, HG_VDIM,
                          MLA_Q_RANK, MLA_KV_RANK]).tolist()

    h = _layernorm(x, ln_in_g, ln_in_b)
    for l in range(DEPTH):
        proj = h @ w_in[l]
        q_raw, i_raw, ff_raw, fb_raw, g_raw, qa, kva, kr = jnp.split(proj, split_at, axis=-1)
        hg = _hgrn2_group(q_raw, i_raw, ff_raw, fb_raw, g_raw, lbs_f[l], lbs_b[l], hg_norm_g[l])
        at = _mla_group(qa, kva, kr, cos, sin, q_a_norm_g[l], w_q_b[l], kv_a_norm_g[l],
                        w_kv_b[l], attn_norm_g[l])
        mix = jnp.concatenate([hg, at.astype(hg.dtype)], axis=-1) @ w_out[l]
        h = _layernorm(DN_ALPHA * h + mix, ln1_g[l], ln1_b[l])
        ffn = _conv_glu_ffn(h, w_up[l], conv_w[l], conv_b[l], w_down[l])
        h = _layernorm(DN_ALPHA * h + ffn, ln2_g[l], ln2_b[l])
    return h
```

```cpp
#include <hip/hip_runtime.h>
#include <hip/hip_cooperative_groups.h>
#include <cstdio>
#include <cstdint>
namespace cg = cooperative_groups;

#ifndef MK_ONE_LAUNCH
#define MK_ONE_LAUNCH 1
#endif
#ifndef MK_NAIVE
#define MK_NAIVE 0x04
#endif
constexpr unsigned NAIVE = MK_NAIVE;
constexpr unsigned NV_IN = 1, NV_QKV = 2, NV_ATT = 4, NV_OUT = 8, NV_UP = 16, NV_DOWN = 32;

constexpr int BATCH = 8, SEQ = 2048, DM = 1024, M = BATCH * SEQ;
constexpr int INC = 3136, INCP = 3328;
constexpr int HGW = 512;
constexpr int QRANK = 384, KVRANK = 128, ROPE = 64, NOPE = 128;
constexpr int NQ = 4 * (NOPE + ROPE);
constexpr int NKV = 4 * (NOPE + 128);
constexpr int DFF = 2816, NUP = 2 * DFF;
constexpr float DN_ALPHA = 1.189207115002721f;
constexpr float EPS = 1e-5f;
constexpr float ATT_SCALE = 0.07216878364870322f;

constexpr int PC_Q = 0, PC_V = 512, PC_FF = 1024, PC_FB = 1536, PC_G = 2048, PC_QA = 2560, PC_KVA = 2944, PC_KR = 3072;

constexpr size_t MiB = 1u << 20;
constexpr size_t WS_CTL = 0;
constexpr size_t WS_WIN = 1 * MiB;
constexpr size_t WS_WQB = WS_WIN + (size_t)INCP * DM * 2;
constexpr size_t WS_WKVB = WS_WQB + (size_t)NQ * QRANK * 2;
constexpr size_t WS_WOUT = WS_WKVB + (size_t)NKV * KVRANK * 2;
constexpr size_t WS_WUP = WS_WOUT + (size_t)DM * DM * 2;
constexpr size_t WS_WDN = WS_WUP + (size_t)NUP * DM * 2;
constexpr size_t WS_WEND = WS_WDN + (size_t)DM * DFF * 2;
static_assert(WS_WEND <= 27 * MiB, "weights");
constexpr size_t WS_COS = 27 * MiB, WS_SIN = 29 * MiB;
constexpr size_t WS_MU0 = 31 * MiB, WS_RS0 = WS_MU0 + 65536, WS_LBF = WS_RS0 + 65536, WS_LBB = WS_LBF + 2048;
constexpr size_t WS_SSQQ = WS_LBB + 2048, WS_SSQKV = WS_SSQQ + (size_t)M * 8 * 4;
static_assert(WS_SSQKV + (size_t)M * 4 * 4 <= 32 * MiB, "small");
constexpr size_t WS_XN = 32 * MiB, WS_MIXA = 32 * MiB;
constexpr size_t WS_QHG = 64 * MiB, WS_VHG = 80 * MiB, WS_GATE = 96 * MiB;
constexpr size_t WS_FF = 112 * MiB, WS_FB = 144 * MiB;
constexpr size_t WS_QA = 176 * MiB, WS_KVA = 188 * MiB, WS_KPE = 192 * MiB;
constexpr size_t WS_QAT = 194 * MiB, WS_KV = 218 * MiB;
constexpr size_t WS_Y = 64 * MiB;
constexpr size_t WS_H1B = 128 * MiB;
constexpr size_t WS_ACT = 160 * MiB;
constexpr size_t WS_HALO = 248 * MiB;
constexpr size_t WS_UH = 32 * MiB;
constexpr size_t WS_END = 254 * MiB;
static_assert(WS_HALO + (size_t)64 * 4 * NUP * 4 <= WS_END, "halo");
static_assert(WS_UH + (size_t)8192 * NUP * 2 <= WS_H1B, "uh");

constexpr int LDS_BYTES = 147456;
constexpr int RING_BYTES = 131072;
constexpr int LDS_BND = RING_BYTES;
constexpr int LDS_MISC = RING_BYTES + 8192;
constexpr int NTHREADS = 512;

#define LAS __attribute__((address_space(3)))
typedef unsigned short bf16_t;
typedef short bf16x8 __attribute__((ext_vector_type(8)));
typedef float f32x4 __attribute__((ext_vector_type(4)));
typedef float f32x2 __attribute__((ext_vector_type(2)));
typedef float f32x16 __attribute__((ext_vector_type(16)));
typedef unsigned u32x4 __attribute__((ext_vector_type(4)));
typedef unsigned u32x2 __attribute__((ext_vector_type(2)));
typedef short s16x4 __attribute__((ext_vector_type(4)));

__device__ __forceinline__ float bf2f(bf16_t h) { return __uint_as_float(((unsigned)h) << 16); }
__device__ __forceinline__ unsigned cvt_pk_bf16(float lo, float hi) { unsigned r; asm volatile("v_cvt_pk_bf16_f32 %0, %1, %2" : "=v"(r) : "v"(lo), "v"(hi)); return r; }
__device__ __forceinline__ float sigmoidf_(float x) { return 1.0f / (1.0f + __expf(-x)); }
__device__ __forceinline__ float siluf_(float x) { return x * sigmoidf_(x); }
__device__ __forceinline__ float gelu_tanh(float x) {
    const float z = 1.5957691216057308f * (x + 0.044715f * x * x * x);
    return x / (1.0f + __expf(-z));
}
__device__ __forceinline__ float wave_sum(float v) {
#pragma unroll
    for (int o = 1; o < 64; o <<= 1) v += __shfl_xor(v, o);
    return v;
}
__device__ __forceinline__ float wave_max(float v) {
#pragma unroll
    for (int o = 1; o < 64; o <<= 1) v = fmaxf(v, __shfl_xor(v, o));
    return v;
}

struct Params {
    const float* in[22];
    float* out;
    unsigned char* ws;
    int ph_lo, ph_hi;
};
enum { I_X = 0, I_POS, I_LNG, I_LNB, I_WIN, I_LBF, I_LBB, I_HGG, I_QAG, I_WQB, I_KVG, I_WKVB, I_ATG, I_WOUT, I_L1G, I_L1B, I_WUP, I_CW, I_CB, I_WDN, I_L2G, I_L2B };

struct RowP { float a, b; };

namespace pg8 {
constexpr int BM = 256, BK = 64, HALF = 128, HTB = HALF * BK * 2, STAGE_BYTES = 8 * HTB, NXCD = 8, WGM = 8;
__host__ __device__ __forceinline__ int lds_byte(int r, int c) { const int st = (r >> 4) * 2 + (c >> 5), rr = r & 15, cc = c & 31, ob = rr * 64 + cc * 2; return st * 1024 + (ob ^ (((ob >> 9) & 1) << 5)); }
__host__ __device__ __forceinline__ void stage_rc(int b, int& R, int& C) { const int st = b / 1024, sb = b % 1024, swz = sb ^ (((sb >> 9) & 1) << 5); R = (st >> 1) * 16 + swz / 64; C = (st & 1) * 32 + (swz % 64) / 2; }
__host__ __device__ __forceinline__ int perm32(int rho) { const int n = rho >> 4, i = rho & 15; return 8 * (i >> 2) + 4 * n + (i & 3); }

struct Unit { int pm, pn; };
struct Gemm { const bf16_t* A; const bf16_t* Bt; int M, N, K; };

template <int MM, int NN> struct StaticOrder {
    static constexpr int nM = MM / BM, nN = NN / BM, nwg = nM * nN; int G, c;
    __host__ __device__ void init(int G_, int c_) { G = G_; c = c_; }
    __host__ __device__ bool next(int i, Unit& u) const {
        const long L = (long)i * G + c; if (L >= nwg) return false;
        int wgid = (int)L; { const int q = nwg / NXCD, r = nwg % NXCD, xcd = wgid % NXCD, off = wgid / NXCD; wgid = (xcd < r ? xcd * (q + 1) : r * (q + 1) + (xcd - r) * q) + off; }
        const int nig = WGM * nN, gid = wgid / nig, fm = gid * WGM, gsz = (nM - fm) < WGM ? (nM - fm) : WGM;
        u.pm = fm + ((wgid % nig) % gsz); u.pn = (wgid % nig) / gsz; return true;
    }
    __device__ __forceinline__ void a_ready(const Unit&) const {}
    __device__ __forceinline__ void done(const Unit&) const {}
};

template <int KK, class Epi, class Sched, bool ALIGN_EPI = false, bool SP2 = false>
__device__ __forceinline__ void gemm_phase(LAS unsigned char* lds, int tid_in, const Gemm g, const Sched& S, const Epi& E) {
    const int tid = tid_in, wid = __builtin_amdgcn_readfirstlane(tid >> 6), lane = tid & 63, wr = wid >> 2, wc = wid & 3, fr = lane & 15, fq = lane >> 4;
    constexpr int K = KK, nt = K / BK;
    unsigned voffA[2], voffB[2];
#pragma unroll
    for (int i = 0; i < 2; ++i) { int R, C; stage_rc(tid * 16 + i * 8192, R, C); const int Rb = Epi::PERM ? ((R & ~31) + perm32(R & 31)) : R;
        voffA[i] = (unsigned)(R * K + C) * 2u; voffB[i] = (unsigned)(Rb * K + C) * 2u; }
    constexpr size_t kstep = (size_t)(BK * 2);
    constexpr size_t hstep = (size_t)HALF * K * 2;
    constexpr size_t tstep = 2 * hstep;
    const unsigned ldsw = (unsigned)wid * 1024u;
    const int aoff = lds_byte(wr * 64 + fr, fq * 8), boff = lds_byte(wc * 32 + fr, fq * 8);
#define PG8_SA(b, h) (((b) * 2 + (h)) * HTB)
#define PG8_SB(b, h) ((4 + (b) * 2 + (h)) * HTB)
#define PG8_STAGE(bufoff, gbase, voff) do { _Pragma("unroll") for (int _i = 0; _i < 2; ++_i) \
        __builtin_amdgcn_global_load_lds((const unsigned*)((const char*)(gbase) + (voff)[_i]), (LAS unsigned*)(lds + (bufoff) + ldsw + _i * 8192), 16, 0, 0); } while (0)
#define PG8_LDA(dst, b, h) do { _Pragma("unroll") for (int m = 0; m < 4; ++m) _Pragma("unroll") for (int k = 0; k < 2; ++k) dst[m][k] = *(const LAS bf16x8*)(lds + PG8_SA(b, h) + aoff + m * 2048 + k * 1024); } while (0)
#define PG8_LDB(dst, b, h) do { _Pragma("unroll") for (int n = 0; n < 2; ++n) _Pragma("unroll") for (int k = 0; k < 2; ++k) dst[n][k] = *(const LAS bf16x8*)(lds + PG8_SB(b, h) + boff + n * 2048 + k * 1024); } while (0)
#define PG8_MMA(ai, bj, At, Bt) do { __builtin_amdgcn_s_setprio(1); _Pragma("unroll") for (int m = 0; m < 4; ++m) _Pragma("unroll") for (int n = 0; n < 2; ++n) _Pragma("unroll") for (int k = 0; k < 2; ++k) \
        acc[ai][bj][m][n] = __builtin_amdgcn_mfma_f32_16x16x32_bf16(Bt[n][k], At[m][k], acc[ai][bj][m][n], 0, 0, 0); __builtin_amdgcn_s_setprio(0); } while (0)
#define PG8_WAIT_V(n) asm volatile("s_waitcnt vmcnt(" #n ")" ::: "memory")
#define PG8_WAIT_L(n) asm volatile("s_waitcnt lgkmcnt(" #n ")" ::: "memory")
#define PG8_BAR __builtin_amdgcn_s_barrier()
#define PG8_SCHED __builtin_amdgcn_sched_barrier(0)
    Unit cur, nxt; int ui = 0;
    if (!S.next(0, cur)) return;
    f32x4 acc[2][2][4][2];
#pragma unroll
    for (int a = 0; a < 2; ++a)
#pragma unroll
        for (int b = 0; b < 2; ++b)
#pragma unroll
            for (int m = 0; m < 4; ++m)
#pragma unroll
                for (int n = 0; n < 2; ++n) acc[a][b][m][n] = (f32x4){0.f, 0.f, 0.f, 0.f};
    bf16x8 At[4][2], B0[2][2], B1[2][2];
    const char* cA = (const char*)g.A + (size_t)cur.pm * tstep; const char* cB = (const char*)g.Bt + (size_t)cur.pn * tstep;
    S.a_ready(cur);
    if constexpr (SP2) {
        PG8_STAGE(PG8_SB(0, 0), cB, voffB); PG8_STAGE(PG8_SB(0, 1), cB + hstep, voffB); PG8_STAGE(PG8_SA(0, 0), cA, voffA); PG8_STAGE(PG8_SA(0, 1), cA + hstep, voffA);
        if (wr == 1) PG8_BAR;
        PG8_WAIT_V(2); PG8_BAR;
        PG8_STAGE(PG8_SB(1, 0), cB + kstep, voffB); PG8_STAGE(PG8_SA(1, 0), cA + kstep, voffA); PG8_STAGE(PG8_SB(1, 1), cB + hstep + kstep, voffB);
        PG8_WAIT_V(6); PG8_BAR;
    } else {
        PG8_STAGE(PG8_SB(0, 0), cB, voffB); PG8_STAGE(PG8_SA(0, 0), cA, voffA); PG8_STAGE(PG8_SB(0, 1), cB + hstep, voffB); PG8_STAGE(PG8_SA(0, 1), cA + hstep, voffA);
        if (wr == 1) PG8_BAR;
        PG8_WAIT_V(4); PG8_BAR;
        PG8_STAGE(PG8_SB(1, 0), cB + kstep, voffB); PG8_STAGE(PG8_SA(1, 0), cA + kstep, voffA); PG8_STAGE(PG8_SB(1, 1), cB + hstep + kstep, voffB);
        PG8_WAIT_V(6); PG8_BAR;
    }
    for (;;) {
        const bool has_next = S.next(ui + 1, nxt);
        const char* nA = has_next ? (const char*)g.A + (size_t)nxt.pm * tstep : cA; const char* nB = has_next ? (const char*)g.Bt + (size_t)nxt.pn * tstep : cB;
#pragma unroll 1
        for (int t = 0; t < nt; t += 2) {
            const bool last = (t == nt - 2);
            const char* a1 = cA + (size_t)(t + 1) * kstep;
            const char* a2 = last ? nA : cA + (size_t)(t + 2) * kstep; const char* b2 = last ? nB : cB + (size_t)(t + 2) * kstep;
            const char* a3 = a2 + kstep; const char* b3 = b2 + kstep;
            if (last && has_next) S.a_ready(nxt);
            if constexpr (SP2) {
            PG8_LDB(B0, 0, 0); PG8_LDB(B1, 0, 1); PG8_SCHED; PG8_LDA(At, 0, 0); PG8_STAGE(PG8_SA(1, 1), a1 + hstep, voffA);
            PG8_WAIT_V(8); PG8_WAIT_L(0); PG8_BAR; PG8_MMA(0, 0, At, B0); PG8_MMA(0, 1, At, B1); PG8_BAR; PG8_SCHED;
            PG8_LDA(At, 0, 1); PG8_STAGE(PG8_SB(0, 0), b2, voffB); PG8_STAGE(PG8_SB(0, 1), b2 + hstep, voffB); PG8_STAGE(PG8_SA(0, 0), a2, voffA);
            PG8_WAIT_V(8); PG8_WAIT_L(0); PG8_BAR; PG8_MMA(1, 0, At, B0); PG8_MMA(1, 1, At, B1); PG8_BAR; PG8_SCHED;
            PG8_LDB(B0, 1, 0); PG8_LDB(B1, 1, 1); PG8_SCHED; PG8_LDA(At, 1, 0); PG8_STAGE(PG8_SA(0, 1), a2 + hstep, voffA);
            PG8_WAIT_V(8); PG8_WAIT_L(0); PG8_BAR; PG8_MMA(0, 0, At, B0); PG8_MMA(0, 1, At, B1); PG8_BAR; PG8_SCHED;
            PG8_LDA(At, 1, 1); PG8_STAGE(PG8_SB(1, 0), b3, voffB); PG8_STAGE(PG8_SB(1, 1), b3 + hstep, voffB); PG8_STAGE(PG8_SA(1, 0), a3, voffA);
            PG8_WAIT_V(8); PG8_WAIT_L(0); PG8_BAR; PG8_MMA(1, 0, At, B0); PG8_MMA(1, 1, At, B1); PG8_BAR; PG8_SCHED;
            } else {
            PG8_LDB(B0, 0, 0); PG8_SCHED; PG8_LDA(At, 0, 0); PG8_STAGE(PG8_SA(1, 1), a1 + hstep, voffA);
            PG8_WAIT_L(8); PG8_BAR; PG8_WAIT_L(0); PG8_MMA(0, 0, At, B0); PG8_BAR; PG8_SCHED;
            PG8_LDB(B1, 0, 1); PG8_STAGE(PG8_SB(0, 0), b2, voffB);
            PG8_BAR; PG8_WAIT_L(0); PG8_MMA(0, 1, At, B1); PG8_BAR;
            PG8_LDA(At, 0, 1); PG8_STAGE(PG8_SA(0, 0), a2, voffA);
            PG8_BAR; PG8_WAIT_L(0); PG8_MMA(1, 0, At, B0); PG8_BAR; PG8_SCHED;
            PG8_STAGE(PG8_SB(0, 1), b2 + hstep, voffB);
            PG8_WAIT_V(6); PG8_BAR; PG8_MMA(1, 1, At, B1); PG8_BAR;
            PG8_LDB(B0, 1, 0); PG8_SCHED; PG8_LDA(At, 1, 0); PG8_STAGE(PG8_SA(0, 1), a2 + hstep, voffA);
            PG8_WAIT_L(8); PG8_BAR; PG8_WAIT_L(0); PG8_MMA(0, 0, At, B0); PG8_BAR; PG8_SCHED;
            PG8_LDB(B1, 1, 1); PG8_STAGE(PG8_SB(1, 0), b3, voffB);
            PG8_BAR; PG8_WAIT_L(0); PG8_MMA(0, 1, At, B1); PG8_BAR;
            PG8_LDA(At, 1, 1); PG8_STAGE(PG8_SA(1, 0), a3, voffA);
            PG8_BAR; PG8_WAIT_L(0); PG8_MMA(1, 0, At, B0); PG8_BAR; PG8_SCHED;
            PG8_STAGE(PG8_SB(1, 1), b3 + hstep, voffB);
            PG8_WAIT_V(6); PG8_BAR; PG8_MMA(1, 1, At, B1); PG8_BAR;
            }
        }
        if constexpr (ALIGN_EPI) { if (wr == 0) PG8_BAR; }
        if constexpr (!Epi::AFTER_DRAIN) { E(acc, cur, wr, wc, fr, fq); S.done(cur); }
        if (!has_next) break;
#pragma unroll
        for (int a = 0; a < 2; ++a)
#pragma unroll
            for (int b = 0; b < 2; ++b)
#pragma unroll
                for (int m = 0; m < 4; ++m)
#pragma unroll
                    for (int n = 0; n < 2; ++n) acc[a][b][m][n] = (f32x4){0.f, 0.f, 0.f, 0.f};
        cur = nxt; cA = nA; cB = nB; ++ui;
        if constexpr (ALIGN_EPI) { if (wr == 1) PG8_BAR; }
    }
    PG8_WAIT_V(0);
    if constexpr (!ALIGN_EPI) { if (wr == 0) PG8_BAR; }
    PG8_BAR;
    if constexpr (Epi::AFTER_DRAIN) { E.fused(acc, cur, wr, wc, fr, fq, lds, wid, lane); S.done(cur); }
#undef PG8_SA
#undef PG8_SB
#undef PG8_STAGE
#undef PG8_LDA
#undef PG8_LDB
#undef PG8_MMA
#undef PG8_WAIT_V
#undef PG8_WAIT_L
#undef PG8_BAR
#undef PG8_SCHED
}

template <class Q> struct EpiQuad {
    static constexpr bool PERM = false, AFTER_DRAIN = false; Q q;
    __device__ __forceinline__ void operator()(const f32x4 (&acc)[2][2][4][2], const Unit& u, int wr, int wc, int fr, int fq) const {
#pragma unroll
        for (int ai = 0; ai < 2; ++ai)
#pragma unroll
            for (int m = 0; m < 4; ++m) { const int r = u.pm * BM + ai * HALF + wr * 64 + m * 16 + fr; const RowP rp = q.row_prep(r);
#pragma unroll
                for (int bj = 0; bj < 2; ++bj)
#pragma unroll
                    for (int n = 0; n < 2; ++n) q.quad(r, u.pn * BM + bj * HALF + wc * 32 + n * 16 + fq * 4, acc[ai][bj][m][n], rp);
                asm volatile("" ::: "memory"); }
    }
};
}

__device__ __forceinline__ void st_bf16x4(bf16_t* p, f32x4 v) { u32x2 w; w.x = cvt_pk_bf16(v[0], v[1]); w.y = cvt_pk_bf16(v[2], v[3]); *(u32x2*)p = w; }
__device__ __forceinline__ f32x4 rope4(f32x4 v, const float* cosr, const float* sinr, int i0) {
    const float c0 = cosr[i0], s0 = sinr[i0], c1 = cosr[i0 + 1], s1 = sinr[i0 + 1];
    return (f32x4){v[0] * c0 - v[1] * s0, v[1] * c0 + v[0] * s0, v[2] * c1 - v[3] * s1, v[3] * c1 + v[2] * s1};
}

struct QInProj {
    bf16_t *QHG, *VHG, *GATE, *QA, *KVA, *KPE; float *FF, *FB; const float *LBF, *LBB, *COS, *SIN;
    __device__ __forceinline__ RowP row_prep(int) const { return RowP{0.f, 0.f}; }
    __device__ __forceinline__ void quad(int r, int c, f32x4 v, RowP) const {
        if (c < PC_V) { st_bf16x4(QHG + (size_t)r * HGW + c, (f32x4){siluf_(v[0]), siluf_(v[1]), siluf_(v[2]), siluf_(v[3])}); }
        else if (c < PC_FF) { st_bf16x4(VHG + (size_t)r * HGW + (c - PC_V), v); }
        else if (c < PC_G) { const bool fw = c < PC_FB; const int cc = c - (fw ? PC_FF : PC_FB); const f32x4 lb = *(const f32x4*)((fw ? LBF : LBB) + cc);
            f32x4 f;
#pragma unroll
            for (int j = 0; j < 4; ++j) f[j] = lb[j] + (1.0f - lb[j]) * sigmoidf_(v[j]);
            *(f32x4*)((fw ? FF : FB) + (size_t)r * HGW + cc) = f; }
        else if (c < PC_QA) { st_bf16x4(GATE + (size_t)r * HGW + (c - PC_G), (f32x4){siluf_(v[0]), siluf_(v[1]), siluf_(v[2]), siluf_(v[3])}); }
        else if (c < PC_KVA) { st_bf16x4(QA + (size_t)r * QRANK + (c - PC_QA), v); }
        else if (c < PC_KR) { st_bf16x4(KVA + (size_t)r * KVRANK + (c - PC_KVA), v); }
        else if (c < INC) { const int e = c - PC_KR; st_bf16x4(KPE + (size_t)r * ROPE + e, rope4(v, COS + (size_t)r * 32, SIN + (size_t)r * 32, e >> 1)); }
    }
};
struct QQb {
    bf16_t* QAT; const float *SSQQ, *COS, *SIN;
    __device__ __forceinline__ RowP row_prep(int r) const { const f32x4 a = *(const f32x4*)(SSQQ + (size_t)r * 8), b = *(const f32x4*)(SSQQ + (size_t)r * 8 + 4);
        const float s = ((a[0] + a[1]) + (a[2] + a[3])) + ((b[0] + b[1]) + (b[2] + b[3])); return RowP{1.0f / sqrtf(s * (1.0f / QRANK) + EPS), 0.f}; }
    __device__ __forceinline__ void quad(int r, int c, f32x4 v, RowP rp) const {
        v = v * rp.a; const int d = c % 192;
        if (d >= NOPE) v = rope4(v, COS + (size_t)r * 32, SIN + (size_t)r * 32, (d - NOPE) >> 1);
        st_bf16x4(QAT + (size_t)r * NQ + c, v);
    }
};
struct QKvb {
    bf16_t* KV; const float* SSQKV;
    __device__ __forceinline__ RowP row_prep(int r) const { const f32x4 a = *(const f32x4*)(SSQKV + (size_t)r * 4);
        return RowP{1.0f / sqrtf(((a[0] + a[1]) + (a[2] + a[3])) * (1.0f / KVRANK) + EPS), 0.f}; }
    __device__ __forceinline__ void quad(int r, int c, f32x4 v, RowP rp) const { st_bf16x4(KV + (size_t)r * NKV + c, v * rp.a); }
};
struct QOut {
    float* Y; const float *X, *MU0, *RS0, *G, *Bv;
    __device__ __forceinline__ RowP row_prep(int r) const { return RowP{MU0[r], RS0[r]}; }
    __device__ __forceinline__ void quad(int r, int c, f32x4 v, RowP rp) const {
        const f32x4 x = *(const f32x4*)(X + (size_t)r * DM + c), g = *(const f32x4*)(G + c), b = *(const f32x4*)(Bv + c);
        const f32x4 h0 = (x - rp.a) * rp.b * g + b;
        *(f32x4*)(Y + (size_t)r * DM + c) = h0 * DN_ALPHA + v;
    }
};
struct QUpNaive {
    bf16_t* UH; int r0;
    __device__ __forceinline__ RowP row_prep(int) const { return RowP{0.f, 0.f}; }
    __device__ __forceinline__ void quad(int r, int c, f32x4 v, RowP) const { st_bf16x4(UH + (size_t)(r - r0) * NUP + c, v); }
};
struct QDown {
    float* Y; const float* H1;
    __device__ __forceinline__ RowP row_prep(int) const { return RowP{0.f, 0.f}; }
    __device__ __forceinline__ void quad(int r, int c, f32x4 v, RowP) const {
        const f32x4 h = *(const f32x4*)(H1 + (size_t)r * DM + c);
        *(f32x4*)(Y + (size_t)r * DM + c) = h * DN_ALPHA + v;
    }
};

struct EpiInProj {
    static constexpr bool PERM = false, AFTER_DRAIN = false; QInProj q; float *SSQQ, *SSQKV;
    __device__ __forceinline__ void operator()(const f32x4 (&acc)[2][2][4][2], const pg8::Unit& u, int wr, int wc, int fr, int fq) const {
        pg8::EpiQuad<QInProj> e{q}; e(acc, u, wr, wc, fr, fq);
        if (u.pn == 10 || u.pn == 11) {
#pragma unroll
            for (int ai = 0; ai < 2; ++ai)
#pragma unroll
                for (int m = 0; m < 4; ++m) { const int r = u.pm * 256 + ai * 128 + wr * 64 + m * 16 + fr; float s[2];
#pragma unroll
                    for (int bj = 0; bj < 2; ++bj) { float t = 0.f;
#pragma unroll
                        for (int n = 0; n < 2; ++n) { const f32x4 x = acc[ai][bj][m][n]; t += (x[0] * x[0] + x[1] * x[1]) + (x[2] * x[2] + x[3] * x[3]); }
                        t += __shfl_xor(t, 16); t += __shfl_xor(t, 32); s[bj] = t; }
                    if (fq == 0) { if (u.pn == 10) SSQQ[(size_t)r * 8 + wc] = s[0] + s[1]; else { SSQQ[(size_t)r * 8 + 4 + wc] = s[0]; SSQKV[(size_t)r * 4 + wc] = s[1]; } } }
        }
    }
};

__device__ __forceinline__ float dpp_ror1(float x) { return __int_as_float(__builtin_amdgcn_update_dpp(0, __float_as_int(x), 0x121, 0xF, 0xF, false)); }
__device__ __forceinline__ float dpp_rol1(float x) { return __int_as_float(__builtin_amdgcn_update_dpp(0, __float_as_int(x), 0x12F, 0xF, 0xF, false)); }
struct EpiConvGlu {
    static constexpr bool PERM = true, AFTER_DRAIN = false;
    bf16_t* ACT; float* HALO; const float* CW; const float* CBv; LAS float* bnd;
    __device__ __forceinline__ void operator()(const f32x4 (&acc)[2][2][4][2], const pg8::Unit& u, int wr, int wc, int fr, int fq) const {
        const int chl = wc * 32 + fq * 8;
#pragma unroll
        for (int ai = 0; ai < 2; ++ai) { const int gq = 2 * ai + wr;
            if (fr == 0) {
#pragma unroll
                for (int bj = 0; bj < 2; ++bj)
#pragma unroll
                    for (int n = 0; n < 2; ++n) *(LAS f32x4*)(bnd + ((gq * 2 + 0) * 2 + bj) * 128 + chl + 4 * n) = acc[ai][bj][0][n]; }
            if (fr == 15) {
#pragma unroll
                for (int bj = 0; bj < 2; ++bj)
#pragma unroll
                    for (int n = 0; n < 2; ++n) *(LAS f32x4*)(bnd + ((gq * 2 + 1) * 2 + bj) * 128 + chl + 4 * n) = acc[ai][bj][3][n]; } }
        if (wr == 0 && fr < 2) {
#pragma unroll
            for (int bj = 0; bj < 2; ++bj)
#pragma unroll
                for (int n = 0; n < 2; ++n) *(f32x4*)(HALO + ((size_t)u.pm * 4 + fr) * NUP + bj * DFF + u.pn * 128 + chl + 4 * n) = acc[0][bj][0][n]; }
        if (wr == 1 && fr >= 14) {
#pragma unroll
            for (int bj = 0; bj < 2; ++bj)
#pragma unroll
                for (int n = 0; n < 2; ++n) *(f32x4*)(HALO + ((size_t)u.pm * 4 + (fr - 12)) * NUP + bj * DFF + u.pn * 128 + chl + 4 * n) = acc[1][bj][3][n]; }
        asm volatile("s_waitcnt lgkmcnt(0)" ::: "memory"); __builtin_amdgcn_s_barrier(); asm volatile("" ::: "memory");
        unsigned outw[2][4][4];
#pragma unroll
        for (int ai = 0; ai < 2; ++ai) { const int gq = 2 * ai + wr;
#pragma unroll
          for (int n = 0; n < 2; ++n)
#pragma unroll
            for (int jp = 0; jp < 2; ++jp) {
                float val[2][4];
#pragma unroll
                for (int jj = 0; jj < 2; ++jj) { const int j = 2 * jp + jj, cl = chl + 4 * n + j, ch = u.pn * 128 + cl;
                    const float wa0 = CW[ch], wa1 = CW[NUP + ch], wa2 = CW[2 * NUP + ch], ba = CBv[ch];
                    const float wb0 = CW[DFF + ch], wb1 = CW[NUP + DFF + ch], wb2 = CW[2 * NUP + DFF + ch], bb = CBv[DFF + ch];
                    const float pbA = gq > 0 ? bnd[(((gq - 1) * 2 + 1) * 2 + 0) * 128 + cl] : 0.f, pbB = gq > 0 ? bnd[(((gq - 1) * 2 + 1) * 2 + 1) * 128 + cl] : 0.f;
                    const float nbA = gq < 3 ? bnd[(((gq + 1) * 2 + 0) * 2 + 0) * 128 + cl] : 0.f, nbB = gq < 3 ? bnd[(((gq + 1) * 2 + 0) * 2 + 1) * 128 + cl] : 0.f;
                    float xa[4], xb[4], Ra[4], La[4], Rb[4], Lb[4];
#pragma unroll
                    for (int m = 0; m < 4; ++m) { xa[m] = acc[ai][0][m][n][j]; xb[m] = acc[ai][1][m][n][j]; Ra[m] = dpp_ror1(xa[m]); La[m] = dpp_rol1(xa[m]); Rb[m] = dpp_ror1(xb[m]); Lb[m] = dpp_rol1(xb[m]); }
#pragma unroll
                    for (int m = 0; m < 4; ++m) {
                        const float pa = fr > 0 ? Ra[m] : (m > 0 ? Ra[m > 0 ? m - 1 : 0] : pbA), pb = fr > 0 ? Rb[m] : (m > 0 ? Rb[m > 0 ? m - 1 : 0] : pbB);
                        const float na = fr < 15 ? La[m] : (m < 3 ? La[m < 3 ? m + 1 : 3] : nbA), nb = fr < 15 ? Lb[m] : (m < 3 ? Lb[m < 3 ? m + 1 : 3] : nbB);
                        const float ca = wa0 * pa + wa1 * xa[m] + wa2 * na + ba, cb = wb0 * pb + wb1 * xb[m] + wb2 * nb + bb;
                        val[jj][m] = gelu_tanh(ca) * cb; } }
#pragma unroll
                for (int m = 0; m < 4; ++m) outw[ai][m][n * 2 + jp] = cvt_pk_bf16(val[0][m], val[1][m]);
            } }
#pragma unroll
        for (int ai = 0; ai < 2; ++ai)
#pragma unroll
            for (int m = 0; m < 4; ++m) { const int tr = ai * 128 + wr * 64 + m * 16 + fr;
                if (tr != 0 && tr != 255) *(u32x4*)(ACT + (size_t)(u.pm * 256 + tr) * DFF + u.pn * 128 + chl) = (u32x4){outw[ai][m][0], outw[ai][m][1], outw[ai][m][2], outw[ai][m][3]}; }
    }
};

template <class Q>
__device__ __forceinline__ void naive_gemm(LAS unsigned char* lds, int tid, const bf16_t* A, int lda, const bf16_t* Bt, int ldb, int row0, int nrows, int N, int K, const Q& q) {
    LAS float* As = (LAS float*)lds;
    LAS float* Bs = As + 16 * 132;
    const int ty = tid >> 4, tx = tid & 15;
    const int tiles_n = N / 64, ntiles = (nrows / 128) * tiles_n;
    for (int t = blockIdx.x; t < ntiles; t += gridDim.x) {
        const int tm = t / tiles_n, tn = t % tiles_n;
        float acc[4][4];
#pragma unroll
        for (int i = 0; i < 4; ++i)
#pragma unroll
            for (int j = 0; j < 4; ++j) acc[i][j] = 0.f;
        for (int k0 = 0; k0 < K; k0 += 16) {
            { const int row = tid >> 2, kk = (tid & 3) * 4; const ushort4 v = *(const ushort4*)(A + (size_t)(row0 + tm * 128 + row) * lda + k0 + kk);
              As[(kk + 0) * 132 + row] = bf2f(v.x); As[(kk + 1) * 132 + row] = bf2f(v.y); As[(kk + 2) * 132 + row] = bf2f(v.z); As[(kk + 3) * 132 + row] = bf2f(v.w); }
            if (tid < 256) { const int n = tid >> 2, kk = (tid & 3) * 4; const ushort4 v = *(const ushort4*)(Bt + (size_t)(tn * 64 + n) * ldb + k0 + kk);
              Bs[(kk + 0) * 68 + n] = bf2f(v.x); Bs[(kk + 1) * 68 + n] = bf2f(v.y); Bs[(kk + 2) * 68 + n] = bf2f(v.z); Bs[(kk + 3) * 68 + n] = bf2f(v.w); }
            __syncthreads();
#pragma unroll
            for (int kk = 0; kk < 16; ++kk) {
                const f32x4 a = *(const LAS f32x4*)(As + kk * 132 + ty * 4), b = *(const LAS f32x4*)(Bs + kk * 68 + tx * 4);
#pragma unroll
                for (int i = 0; i < 4; ++i)
#pragma unroll
                    for (int j = 0; j < 4; ++j) acc[i][j] = fmaf(a[i], b[j], acc[i][j]);
            }
            __syncthreads();
        }
#pragma unroll
        for (int i = 0; i < 4; ++i) { const int r = row0 + tm * 128 + ty * 4 + i; const RowP rp = q.row_prep(r); q.quad(r, tn * 64 + tx * 4, (f32x4){acc[i][0], acc[i][1], acc[i][2], acc[i][3]}, rp); }
    }
}

struct Frame {
    LAS unsigned char* lds; int tid, lane, wave, G, bid, vcu;
    const float* const* in; float* out; unsigned char* ws;
};
template <class T> __device__ __forceinline__ T* wsp(const Frame& F, size_t off) { return (T*)(F.ws + off); }

template <class PhysFn>
__device__ __forceinline__ void transpose_item(const float* W, int K, int N, bf16_t* WT, const float* kscale, LAS float* scr, int item, int lane, PhysFn phys) {
    const int nblk = N / 32, kb = item / nblk, nb = item % nblk, k0 = 64 * kb, n0 = 32 * nb;
#pragma unroll 8
    for (int i = 0; i < 32; ++i) { const int kk = 2 * i + (lane >> 5); float w = W[(size_t)(k0 + kk) * N + n0 + (lane & 31)]; if (kscale) w *= kscale[k0 + kk]; scr[kk * 33 + (lane & 31)] = w; }
    asm volatile("s_waitcnt lgkmcnt(0)" ::: "memory");
    const int c = lane & 7;
#pragma unroll
    for (int j = 0; j < 4; ++j) { const int n = (lane >> 3) + 8 * j; const LAS float* s = scr + (8 * c) * 33 + n;
        u32x4 o; o.x = cvt_pk_bf16(s[0 * 33], s[1 * 33]); o.y = cvt_pk_bf16(s[2 * 33], s[3 * 33]); o.z = cvt_pk_bf16(s[4 * 33], s[5 * 33]); o.w = cvt_pk_bf16(s[6 * 33], s[7 * 33]);
        *(u32x4*)(WT + (size_t)phys(n0 + n) * K + k0 + 8 * c) = o; }
    asm volatile("s_waitcnt lgkmcnt(0)" ::: "memory");
}
__device__ __forceinline__ int phys_id(int n) { return n; }
__device__ __forceinline__ int phys_rope64(int e) { return e < 32 ? 2 * e : 2 * (e - 32) + 1; }
__device__ __forceinline__ int phys_win(int n) { return n < PC_KR ? n : PC_KR + phys_rope64(n - PC_KR); }
__device__ __forceinline__ int phys_wqb(int n) { const int h = n / 192, d = n % 192; return h * 192 + (d < NOPE ? d : NOPE + phys_rope64(d - NOPE)); }
__device__ __forceinline__ int phys_wup(int n) { const int j = n < DFF ? n : n - DFF; return (j >> 7) * 256 + (n < DFF ? 0 : 128) + (j & 127); }

__device__ __forceinline__ void p0_prologue(Frame& F) {
    LAS float* scr = (LAS float*)(F.lds + F.wave * 16384);
    const int gw = F.vcu * 8 + F.wave, NGW = F.G * 8;
    bf16_t* WIN = wsp<bf16_t>(F, WS_WIN); bf16_t* WQB = wsp<bf16_t>(F, WS_WQB); bf16_t* WKVB = wsp<bf16_t>(F, WS_WKVB);
    bf16_t* WOUT = wsp<bf16_t>(F, WS_WOUT); bf16_t* WUP = wsp<bf16_t>(F, WS_WUP); bf16_t* WDN = wsp<bf16_t>(F, WS_WDN);
    constexpr int I_IN = (DM / 64) * (INC / 32), I_QB = (QRANK / 64) * (NQ / 32), I_KVB = (KVRANK / 64) * (NKV / 32), I_OUT = (DM / 64) * (DM / 32), I_UP = (DM / 64) * (NUP / 32), I_DN = (DFF / 64) * (DM / 32);
    constexpr int NITEMS = I_IN + I_QB + I_KVB + I_OUT + I_UP + I_DN;
    for (int it = gw; it < NITEMS; it += NGW) {
        int r = it;
        if (r < I_IN) { transpose_item(F.in[I_WIN], DM, INC, WIN, nullptr, scr, r, F.lane, phys_win); continue; } r -= I_IN;
        if (r < I_QB) { transpose_item(F.in[I_WQB], QRANK, NQ, WQB, F.in[I_QAG], scr, r, F.lane, phys_wqb); continue; } r -= I_QB;
        if (r < I_KVB) { transpose_item(F.in[I_WKVB], KVRANK, NKV, WKVB, F.in[I_KVG], scr, r, F.lane, phys_id); continue; } r -= I_KVB;
        if (r < I_OUT) { transpose_item(F.in[I_WOUT], DM, DM, WOUT, nullptr, scr, r, F.lane, phys_id); continue; } r -= I_OUT;
        if (r < I_UP) { transpose_item(F.in[I_WUP], DM, NUP, WUP, nullptr, scr, r, F.lane, phys_wup); continue; } r -= I_UP;
        transpose_item(F.in[I_WDN], DFF, DM, WDN, nullptr, scr, r, F.lane, phys_id);
    }
    { u32x4* z = (u32x4*)(WIN + (size_t)INC * DM); const int n16 = (INCP - INC) * DM * 2 / 16;
      for (int i = F.bid * NTHREADS + F.tid; i < n16; i += F.G * NTHREADS) z[i] = (u32x4){0u, 0u, 0u, 0u}; }
    { bf16_t* XN = wsp<bf16_t>(F, WS_XN); float* MU0 = wsp<float>(F, WS_MU0); float* RS0 = wsp<float>(F, WS_RS0);
      const float* g = F.in[I_LNG]; const float* bb = F.in[I_LNB];
      for (int m = gw; m < M; m += NGW) {
        const f32x4* xr = (const f32x4*)(F.in[I_X] + (size_t)m * DM) + F.lane;
        f32x4 v[4]; float s = 0.f;
#pragma unroll
        for (int j = 0; j < 4; ++j) { v[j] = xr[64 * j]; s += (v[j][0] + v[j][1]) + (v[j][2] + v[j][3]); }
        const float mean = wave_sum(s) * (1.f / DM); float s2 = 0.f;
#pragma unroll
        for (int j = 0; j < 4; ++j) { const f32x4 d = v[j] - mean; s2 += (d[0] * d[0] + d[1] * d[1]) + (d[2] * d[2] + d[3] * d[3]); }
        const float rstd = 1.f / sqrtf(wave_sum(s2) * (1.f / DM) + EPS);
        if (F.lane == 0) { MU0[m] = mean; RS0[m] = rstd; }
#pragma unroll
        for (int j = 0; j < 4; ++j) { const int c = 4 * F.lane + 256 * j; const f32x4 gg = *(const f32x4*)(g + c), bv = *(const f32x4*)(bb + c);
            st_bf16x4(XN + (size_t)m * DM + c, (v[j] - mean) * rstd * gg + bv); }
      } }
    { float* COS = wsp<float>(F, WS_COS); float* SIN = wsp<float>(F, WS_SIN); const int* pos = (const int*)F.in[I_POS];
      for (int i = F.bid * NTHREADS + F.tid; i < M * 32; i += F.G * NTHREADS) { const int m = i >> 5, k = i & 31;
        const float invf = 1.0f / powf(10000.0f, (float)k * (1.0f / 32.0f));
        const float ang = (float)pos[m] * invf;
        const double rev = (double)ang * 0.15915494309189535; const float fr = (float)(rev - floor(rev));
        COS[i] = __builtin_amdgcn_cosf(fr); SIN[i] = __builtin_amdgcn_sinf(fr); }
      float* LBF = wsp<float>(F, WS_LBF); float* LBB = wsp<float>(F, WS_LBB);
      for (int i = F.bid * NTHREADS + F.tid; i < 2 * HGW; i += F.G * NTHREADS) { const bool fw = i < HGW; const int c = fw ? i : i - HGW; const float* lb = fw ? F.in[I_LBF] : F.in[I_LBB];
        const float v = 1.0f / (1.0f + __expf(lb[HGW + c] - lb[c])); (fw ? LBF : LBB)[c] = v; } }
}

__device__ __forceinline__ void p_ssq_naive(Frame& F) {
    const bf16_t* QA = wsp<bf16_t>(F, WS_QA); const bf16_t* KVA = wsp<bf16_t>(F, WS_KVA); float* SSQQ = wsp<float>(F, WS_SSQQ); float* SSQKV = wsp<float>(F, WS_SSQKV);
    const int gw = F.bid * 8 + F.wave, NGW = F.G * 8;
    for (int m = gw; m < M; m += NGW) {
        float s = 0.f;
        for (int c = F.lane; c < QRANK; c += 64) { const float v = bf2f(QA[(size_t)m * QRANK + c]); s += v * v; }
        s = wave_sum(s);
        float t = 0.f;
        for (int c = F.lane; c < KVRANK; c += 64) { const float v = bf2f(KVA[(size_t)m * KVRANK + c]); t += v * v; }
        t = wave_sum(t);
        if (F.lane < 8) SSQQ[(size_t)m * 8 + F.lane] = F.lane == 0 ? s : 0.f;
        if (F.lane < 4) SSQKV[(size_t)m * 4 + F.lane] = F.lane == 0 ? t : 0.f;
    }
}

__device__ __forceinline__ void p_attn_naive(Frame& F) {
    const bf16_t* QAT = wsp<bf16_t>(F, WS_QAT); const bf16_t* KV = wsp<bf16_t>(F, WS_KV); const bf16_t* KPE = wsp<bf16_t>(F, WS_KPE); bf16_t* MIXA = wsp<bf16_t>(F, WS_MIXA);
    const float* g = F.in[I_ATG];
    LAS float* qs = (LAS float*)F.lds + F.wave * 192;
    LAS float* ps = (LAS float*)(F.lds + 8192) + F.wave * 2048;
    const int gw = F.bid * 8 + F.wave, NGW = F.G * 8;
    for (int item = gw; item < M * 4; item += NGW) {
        const int b = item / (4 * SEQ), h = (item / SEQ) % 4, t = item % SEQ; const size_t m = (size_t)b * SEQ + t;
        for (int d = F.lane; d < 192; d += 64) qs[d] = bf2f(QAT[m * NQ + h * 192 + d]);
        asm volatile("s_waitcnt lgkmcnt(0)" ::: "memory");
        float mx = -1e30f;
#pragma unroll 1
        for (int i = 0; i < 32; ++i) { const size_t kr = (size_t)b * SEQ + F.lane + 64 * i; float s = 0.f;
            const bf16_t* kn = KV + kr * NKV + h * 256;
#pragma unroll 4
            for (int d = 0; d < 128; d += 8) { const bf16x8 kv = *(const bf16x8*)(kn + d);
#pragma unroll
                for (int j = 0; j < 8; ++j) s = fmaf(qs[d + j], bf2f((bf16_t)kv[j]), s); }
            const bf16_t* kp = KPE + kr * ROPE;
#pragma unroll 4
            for (int d = 0; d < 64; d += 8) { const bf16x8 kv = *(const bf16x8*)(kp + d);
#pragma unroll
                for (int j = 0; j < 8; ++j) s = fmaf(qs[128 + d + j], bf2f((bf16_t)kv[j]), s); }
            s *= ATT_SCALE; ps[F.lane + 64 * i] = s; mx = fmaxf(mx, s); }
        mx = wave_max(mx); float sum = 0.f;
#pragma unroll 1
        for (int i = 0; i < 32; ++i) { const float pv = __expf(ps[F.lane + 64 * i] - mx); sum += pv; ps[F.lane + 64 * i] = pv; }
        sum = wave_sum(sum);
        asm volatile("s_waitcnt lgkmcnt(0)" ::: "memory");
        float o0 = 0.f, o1 = 0.f; const bf16_t* vb = KV + (size_t)b * SEQ * NKV + h * 256 + 128 + 2 * F.lane;
        for (int j = 0; j < SEQ; ++j) { const unsigned w = *(const unsigned*)(vb + (size_t)j * NKV); const float pj = ps[j];
            o0 = fmaf(pj, __uint_as_float(w << 16), o0); o1 = fmaf(pj, __uint_as_float(w & 0xffff0000u), o1); }
        const float inv = 1.0f / sum; o0 *= inv; o1 *= inv;
        const float ss = wave_sum(o0 * o0 + o1 * o1); const float rs = 1.0f / sqrtf(ss * (1.0f / 128.0f) + EPS);
        *(unsigned*)(MIXA + m * DM + 512 + h * 128 + 2 * F.lane) = cvt_pk_bf16(o0 * rs * g[2 * F.lane], o1 * rs * g[2 * F.lane + 1]);
        asm volatile("s_waitcnt lgkmcnt(0)" ::: "memory");
    }
}

__device__ __forceinline__ void p_hgrn_scan(Frame& F) {
    const bf16_t* QHG = wsp<bf16_t>(F, WS_QHG); const bf16_t* VHG = wsp<bf16_t>(F, WS_VHG); const float* FFp = wsp<float>(F, WS_FF); const float* FBp = wsp<float>(F, WS_FB);
    float* OF = F.out; float* OB = F.out + (size_t)M * HGW;
    LAS float* qs = (LAS float*)F.lds;
    LAS float* fs = qs + 32 * 128;
    LAS float* vs_ = fs + 32 * 128;
    LAS float* op = vs_ + 32 * 32;
    const int tid = F.tid, vv = tid & 31, ks = tid >> 5;
    for (int item = F.bid; item < 256; item += F.G) {
        const int vsl = item & 3, dir = (item >> 2) & 1, h = (item >> 3) & 3, b = item >> 5;
        const float* Fp = dir ? FBp : FFp; float* O = dir ? OB : OF;
        float S[8];
#pragma unroll
        for (int j = 0; j < 8; ++j) S[j] = 0.f;
        for (int c = 0; c < SEQ / 32; ++c) {
            { const int i = tid >> 4, k0 = (tid & 15) * 8; const int s = c * 32 + i, t = dir ? SEQ - 1 - s : s; const size_t row = (size_t)b * SEQ + t;
              const bf16x8 qv = *(const bf16x8*)(QHG + row * HGW + h * 128 + k0);
              const f32x4 f0 = *(const f32x4*)(Fp + row * HGW + h * 128 + k0), f1 = *(const f32x4*)(Fp + row * HGW + h * 128 + k0 + 4);
#pragma unroll
              for (int j = 0; j < 8; ++j) qs[i * 128 + k0 + j] = bf2f((bf16_t)qv[j]);
              *(LAS f32x4*)(fs + i * 128 + k0) = f0; *(LAS f32x4*)(fs + i * 128 + k0 + 4) = f1;
              if (tid < 128) { const int i2 = tid >> 2, v0 = (tid & 3) * 8; const int s2 = c * 32 + i2, t2 = dir ? SEQ - 1 - s2 : s2; const size_t row2 = (size_t)b * SEQ + t2;
                const bf16x8 vvv = *(const bf16x8*)(VHG + row2 * HGW + h * 128 + vsl * 32 + v0);
#pragma unroll
                for (int j = 0; j < 8; ++j) vs_[i2 * 32 + v0 + j] = bf2f((bf16_t)vvv[j]); } }
            __syncthreads();
            for (int i = 0; i < 32; ++i) {
                const f32x4 q0 = *(const LAS f32x4*)(qs + i * 128 + ks * 8), q1 = *(const LAS f32x4*)(qs + i * 128 + ks * 8 + 4);
                const f32x4 f0 = *(const LAS f32x4*)(fs + i * 128 + ks * 8), f1 = *(const LAS f32x4*)(fs + i * 128 + ks * 8 + 4);
                const float v = vs_[i * 32 + vv]; float o = 0.f;
#pragma unroll
                for (int j = 0; j < 4; ++j) { S[j] = fmaf(f0[j], S[j] - v, v); o = fmaf(S[j], q0[j], o); S[4 + j] = fmaf(f1[j], S[4 + j] - v, v); o = fmaf(S[4 + j], q1[j], o); }
                o += __shfl_xor(o, 32);
                if (F.lane < 32) op[(F.wave * 32 + i) * 32 + vv] = o;
            }
            __syncthreads();
#pragma unroll
            for (int rr = 0; rr < 2; ++rr) { const int i = (tid >> 5) + 16 * rr; float o = 0.f;
#pragma unroll
                for (int w = 0; w < 8; ++w) o += op[(w * 32 + i) * 32 + vv];
                const int s = c * 32 + i, t = dir ? SEQ - 1 - s : s;
                O[((size_t)b * SEQ + t) * HGW + h * 128 + vsl * 32 + vv] = o; }
            __syncthreads();
        }
    }
}

__device__ __forceinline__ void p_hgrn_combine(Frame& F) {
    const float* OF = F.out; const float* OB = F.out + (size_t)M * HGW; const bf16_t* GATE = wsp<bf16_t>(F, WS_GATE); bf16_t* MIXA = wsp<bf16_t>(F, WS_MIXA);
    const float* g = F.in[I_HGG];
    const int gw = F.bid * 8 + F.wave, NGW = F.G * 8;
    for (int m = gw; m < M; m += NGW) {
        const size_t base = (size_t)m * HGW + F.lane * 8;
        const f32x4 a0 = *(const f32x4*)(OF + base), a1 = *(const f32x4*)(OF + base + 4), b0 = *(const f32x4*)(OB + base), b1 = *(const f32x4*)(OB + base + 4);
        const f32x4 o0 = a0 + b0, o1 = a1 + b1;
        float ss = (o0[0] * o0[0] + o0[1] * o0[1]) + (o0[2] * o0[2] + o0[3] * o0[3]) + (o1[0] * o1[0] + o1[1] * o1[1]) + (o1[2] * o1[2] + o1[3] * o1[3]);
        ss += __shfl_xor(ss, 1); ss += __shfl_xor(ss, 2); ss += __shfl_xor(ss, 4); ss += __shfl_xor(ss, 8);
        const float rs = 1.0f / sqrtf(ss * (1.0f / 128.0f) + EPS);
        const int gc = (F.lane & 15) * 8; const f32x4 g0 = *(const f32x4*)(g + gc), g1 = *(const f32x4*)(g + gc + 4);
        const bf16x8 gt = *(const bf16x8*)(GATE + base);
        f32x4 y0, y1;
#pragma unroll
        for (int j = 0; j < 4; ++j) { y0[j] = o0[j] * rs * g0[j] * bf2f((bf16_t)gt[j]); y1[j] = o1[j] * rs * g1[j] * bf2f((bf16_t)gt[4 + j]); }
        u32x4 w; w.x = cvt_pk_bf16(y0[0], y0[1]); w.y = cvt_pk_bf16(y0[2], y0[3]); w.z = cvt_pk_bf16(y1[0], y1[1]); w.w = cvt_pk_bf16(y1[2], y1[3]);
        *(u32x4*)(MIXA + (size_t)m * DM + F.lane * 8) = w;
    }
}

__device__ __forceinline__ void p_ln_pass(Frame& F, const float* Y, const float* g, const float* bb, float* dst, bf16_t* dstb) {
    const int gw = F.bid * 8 + F.wave, NGW = F.G * 8;
    for (int m = gw; m < M; m += NGW) {
        const f32x4* xr = (const f32x4*)(Y + (size_t)m * DM) + F.lane;
        f32x4 v[4]; float s = 0.f;
#pragma unroll
        for (int j = 0; j < 4; ++j) { v[j] = xr[64 * j]; s += (v[j][0] + v[j][1]) + (v[j][2] + v[j][3]); }
        const float mean = wave_sum(s) * (1.f / DM); float s2 = 0.f;
#pragma unroll
        for (int j = 0; j < 4; ++j) { const f32x4 d = v[j] - mean; s2 += (d[0] * d[0] + d[1] * d[1]) + (d[2] * d[2] + d[3] * d[3]); }
        const float rstd = 1.f / sqrtf(wave_sum(s2) * (1.f / DM) + EPS);
#pragma unroll
        for (int j = 0; j < 4; ++j) { const int c = 4 * F.lane + 256 * j; const f32x4 gg = *(const f32x4*)(g + c), bv = *(const f32x4*)(bb + c);
            const f32x4 o = (v[j] - mean) * rstd * gg + bv; *(f32x4*)(dst + (size_t)m * DM + c) = o; if (dstb) st_bf16x4(dstb + (size_t)m * DM + c, o); }
    }
}

__device__ __forceinline__ void p_glu_naive(Frame& F, int hh) {
    const bf16_t* UH = wsp<bf16_t>(F, WS_UH); bf16_t* ACT = wsp<bf16_t>(F, WS_ACT); const float* CW = F.in[I_CW]; const float* CBv = F.in[I_CB];
    const int total = 8192 * (DFF / 8);
    for (int idx = F.bid * NTHREADS + F.tid; idx < total; idx += F.G * NTHREADS) {
        const int tl = idx / (DFF / 8), ch = (idx % (DFF / 8)) * 8; const int t = hh * 8192 + tl, pos = t % SEQ;
        const int pa = (ch >> 7) * 256 + (ch & 127), pb = pa + 128;
        const bool hp = pos > 0, hn = pos < SEQ - 1;
        bf16x8 z = {0, 0, 0, 0, 0, 0, 0, 0};
        const bf16x8 a0 = hp ? *(const bf16x8*)(UH + (size_t)(tl - 1) * NUP + pa) : z, a1 = *(const bf16x8*)(UH + (size_t)tl * NUP + pa), a2 = hn ? *(const bf16x8*)(UH + (size_t)(tl + 1) * NUP + pa) : z;
        const bf16x8 b0 = hp ? *(const bf16x8*)(UH + (size_t)(tl - 1) * NUP + pb) : z, b1 = *(const bf16x8*)(UH + (size_t)tl * NUP + pb), b2 = hn ? *(const bf16x8*)(UH + (size_t)(tl + 1) * NUP + pb) : z;
        float y[8];
#pragma unroll
        for (int j = 0; j < 8; ++j) { const int c = ch + j;
            const float ca = CW[c] * bf2f((bf16_t)a0[j]) + CW[NUP + c] * bf2f((bf16_t)a1[j]) + CW[2 * NUP + c] * bf2f((bf16_t)a2[j]) + CBv[c];
            const float cb = CW[DFF + c] * bf2f((bf16_t)b0[j]) + CW[NUP + DFF + c] * bf2f((bf16_t)b1[j]) + CW[2 * NUP + DFF + c] * bf2f((bf16_t)b2[j]) + CBv[DFF + c];
            y[j] = gelu_tanh(ca) * cb; }
        u32x4 w; w.x = cvt_pk_bf16(y[0], y[1]); w.y = cvt_pk_bf16(y[2], y[3]); w.z = cvt_pk_bf16(y[4], y[5]); w.w = cvt_pk_bf16(y[6], y[7]);
        *(u32x4*)(ACT + (size_t)t * DFF + ch) = w;
    }
}

__device__ __forceinline__ void down_fixup(Frame& F, int pm) {
    const float* HALO = wsp<float>(F, WS_HALO); bf16_t* ACT = wsp<bf16_t>(F, WS_ACT); const float* CW = F.in[I_CW]; const float* CBv = F.in[I_CB];
    for (int idx = F.tid; idx < 2 * DFF; idx += NTHREADS) {
        const int which = idx / DFF, ch = idx % DFF;
        const float* P; const float* C; const float* N;
        if (which == 0) { P = (pm % 8 == 0) ? nullptr : HALO + ((size_t)(pm - 1) * 4 + 3) * NUP; C = HALO + ((size_t)pm * 4 + 0) * NUP; N = HALO + ((size_t)pm * 4 + 1) * NUP; }
        else { P = HALO + ((size_t)pm * 4 + 2) * NUP; C = HALO + ((size_t)pm * 4 + 3) * NUP; N = (pm % 8 == 7) ? nullptr : HALO + ((size_t)(pm + 1) * 4 + 0) * NUP; }
        const float pa = P ? P[ch] : 0.f, pb = P ? P[DFF + ch] : 0.f, na = N ? N[ch] : 0.f, nb = N ? N[DFF + ch] : 0.f;
        const float ca = CW[ch] * pa + CW[NUP + ch] * C[ch] + CW[2 * NUP + ch] * na + CBv[ch];
        const float cb = CW[DFF + ch] * pb + CW[NUP + DFF + ch] * C[DFF + ch] + CW[2 * NUP + DFF + ch] * nb + CBv[DFF + ch];
        const float y = gelu_tanh(ca) * cb;
        ACT[(size_t)(pm * 256 + (which ? 255 : 0)) * DFF + ch] = (bf16_t)(cvt_pk_bf16(y, 0.f) & 0xffffu);
    }
    asm volatile("s_waitcnt vmcnt(0)" ::: "memory");
    __syncthreads();
}


#define XB_TMO      128
#define XB_XCNT(j)  (256  + 64 * (j))
#define XB_XSUB(j)  (1280 + 64 * (j))
#define XB_XGEN(j)  (2304 + 64 * (j))
#define XB_TOP      3328
#define XB_TOPGEN   3392
#define XCD_BAR_WORDS 3456
#define XB_SPIN_CAP (1u << 18)
__device__ __forceinline__ unsigned xb_ld(unsigned* p)              { return __hip_atomic_load(p, __ATOMIC_RELAXED, __HIP_MEMORY_SCOPE_AGENT); }
__device__ __forceinline__ unsigned xb_add(unsigned* p, unsigned v) { return __hip_atomic_fetch_add(p, v, __ATOMIC_RELAXED, __HIP_MEMORY_SCOPE_AGENT); }
__device__ __forceinline__ unsigned xb_xcc_id() { return (unsigned)__builtin_amdgcn_s_getreg((3 << 11) | 20) & 0xFu; }
#define XB_SPIN(cond, bar) do { unsigned _sp = 0; while (cond) { __builtin_amdgcn_s_sleep(1); \
    if ((++_sp & 255u) == 0u) { if (xb_ld(&(bar)[XB_TMO])) break; if (_sp > XB_SPIN_CAP) { atomicAdd(&(bar)[XB_TMO], 1u); break; } } } } while (0)
struct XcdBarrier { unsigned* bar; unsigned x; volatile LAS unsigned* st; };
__device__ __forceinline__ XcdBarrier xcd_barrier_post(unsigned* bar, volatile LAS unsigned* st, int tid) {
    XcdBarrier b; b.bar = bar; b.x = xb_xcc_id(); b.st = st;
    if (tid == 0) (void)xb_add(&bar[XB_XCNT(b.x)], 1u);
    return b;
}
__device__ __forceinline__ void xcd_barrier_complete(unsigned* bar, unsigned x, unsigned G, unsigned& nloc, unsigned& nx) {
    unsigned sum, cnt, mine, sp = 0u;
    for (;;) {
        sum = 0u; cnt = 0u; mine = 0u;
#pragma unroll
        for (unsigned j = 0; j < 16; ++j) { const unsigned c = xb_ld(&bar[XB_XCNT(j)]); sum += c; cnt += (c > 0u) ? 1u : 0u; mine = (j == x) ? c : mine; }
        if (sum == G) break;
        __builtin_amdgcn_s_sleep(1);
        if ((++sp & 255u) == 0u) { if (xb_ld(&bar[XB_TMO])) break; if (sp > XB_SPIN_CAP) { atomicAdd(&bar[XB_TMO], 1u); break; } }
    }
    nloc = mine > 0u ? mine : 1u; nx = cnt > 0u ? cnt : 1u;
}
__device__ __forceinline__ void xcd_barrier(const XcdBarrier& b, int tid, unsigned G) {
    asm volatile("s_waitcnt vmcnt(0)" ::: "memory");
    __syncthreads();
    if (tid == 0) {
        unsigned* bar = b.bar;
        __builtin_amdgcn_s_waitcnt(0);
        unsigned nloc = b.st[0], nx = b.st[1];
        if (nloc == 0u) { xcd_barrier_complete(bar, b.x, G, nloc, nx); b.st[0] = nloc; b.st[1] = nx; }
        const unsigned old = xb_add(&bar[XB_XSUB(b.x)], 1u);
        const unsigned gen = old / nloc;
        if (old + 1u == (gen + 1u) * nloc) {
            __builtin_amdgcn_fence(__ATOMIC_RELEASE, "agent");
            asm volatile("s_waitcnt vmcnt(0)" ::: "memory");
            const unsigned og = xb_add(&bar[XB_TOP], 1u);
            const unsigned tg = og / nx;
            if (og + 1u == (tg + 1u) * nx) xb_add(&bar[XB_TOPGEN], 1u);
            else XB_SPIN(xb_ld(&bar[XB_TOPGEN]) == tg, bar);
            __builtin_amdgcn_fence(__ATOMIC_ACQUIRE, "agent");
            xb_add(&bar[XB_XGEN(b.x)], 1u);
            asm volatile("s_waitcnt vmcnt(0)" ::: "memory");
        } else {
            XB_SPIN(xb_ld(&bar[XB_XGEN(b.x)]) == gen, bar);
            __builtin_amdgcn_fence(__ATOMIC_ACQUIRE, "agent");
            asm volatile("s_waitcnt vmcnt(0)" ::: "memory");
        }
    }
    __syncthreads();
}

constexpr int PH_PRO = 0, PH_INPROJ = 1, PH_SSQ = 2, PH_QKV = 3, PH_ATT = 4, PH_SCAN = 5, PH_COMB = 6, PH_OUT = 7, PH_LN1 = 8, PH_UP = 9, PH_GLU0 = 10, PH_UP1 = 11, PH_GLU1 = 12, PH_FIX = 13, PH_DOWN = 14, PH_LN2 = 15, PH_N = 16;

#ifndef MK_PHMASK
#define MK_PHMASK 0xFFFFFFFFu
#endif
__host__ __device__ constexpr bool phase_on(int ph) {
    return !((ph == PH_SSQ && !(NAIVE & NV_IN)) || ((ph == PH_GLU0 || ph == PH_UP1 || ph == PH_GLU1) && !(NAIVE & NV_UP)) || (ph == PH_FIX && !(!(NAIVE & NV_UP) && (NAIVE & NV_DOWN))));
}
template <int ph> __device__ __forceinline__ void run_phase(const Frame& F0) {
    using namespace pg8;
    if (!((MK_PHMASK >> ph) & 1u)) return;
    Frame F = F0; { int l = (int)__builtin_amdgcn_mbcnt_hi(~0u, __builtin_amdgcn_mbcnt_lo(~0u, 0u)); asm volatile("" : "+v"(l)); F.lane = l; F.tid = F0.wave * 64 + l; }
    if constexpr (ph == PH_PRO) { p0_prologue(F); }
    else if constexpr (ph == PH_INPROJ) {
        QInProj q{wsp<bf16_t>(F, WS_QHG), wsp<bf16_t>(F, WS_VHG), wsp<bf16_t>(F, WS_GATE), wsp<bf16_t>(F, WS_QA), wsp<bf16_t>(F, WS_KVA), wsp<bf16_t>(F, WS_KPE),
                  wsp<float>(F, WS_FF), wsp<float>(F, WS_FB), wsp<float>(F, WS_LBF), wsp<float>(F, WS_LBB), wsp<float>(F, WS_COS), wsp<float>(F, WS_SIN)};
        if (NAIVE & NV_IN) naive_gemm(F.lds, F.tid, wsp<bf16_t>(F, WS_XN), DM, wsp<bf16_t>(F, WS_WIN), DM, 0, M, INCP, DM, q);
        else { Gemm g{wsp<bf16_t>(F, WS_XN), wsp<bf16_t>(F, WS_WIN), M, INCP, DM}; StaticOrder<M, INCP> S; S.init(F.G, F.bid);
               EpiInProj E{q, wsp<float>(F, WS_SSQQ), wsp<float>(F, WS_SSQKV)}; gemm_phase<DM, EpiInProj, StaticOrder<M, INCP>, true, true>(F.lds, F.tid, g, S, E); }
    }
    else if constexpr (ph == PH_SSQ) { if (NAIVE & NV_IN) p_ssq_naive(F); }
    else if constexpr (ph == PH_QKV) {
        QQb qq{wsp<bf16_t>(F, WS_QAT), wsp<float>(F, WS_SSQQ), wsp<float>(F, WS_COS), wsp<float>(F, WS_SIN)};
        QKvb qk{wsp<bf16_t>(F, WS_KV), wsp<float>(F, WS_SSQKV)};
        if (NAIVE & NV_QKV) { naive_gemm(F.lds, F.tid, wsp<bf16_t>(F, WS_QA), QRANK, wsp<bf16_t>(F, WS_WQB), QRANK, 0, M, NQ, QRANK, qq);
                              naive_gemm(F.lds, F.tid, wsp<bf16_t>(F, WS_KVA), KVRANK, wsp<bf16_t>(F, WS_WKVB), KVRANK, 0, M, NKV, KVRANK, qk); }
        else {
#ifndef SKIP_QB
 { Gemm g{wsp<bf16_t>(F, WS_QA), wsp<bf16_t>(F, WS_WQB), M, NQ, QRANK}; StaticOrder<M, NQ> S; S.init(F.G, F.bid); EpiQuad<QQb> E{qq}; gemm_phase<QRANK, EpiQuad<QQb>, StaticOrder<M, NQ>, true, true>(F.lds, F.tid, g, S, E); }
#endif
#ifndef SKIP_KVB
               { Gemm g{wsp<bf16_t>(F, WS_KVA), wsp<bf16_t>(F, WS_WKVB), M, NKV, KVRANK}; StaticOrder<M, NKV> S; S.init(F.G, F.bid); EpiQuad<QKvb> E{qk}; gemm_phase<KVRANK, EpiQuad<QKvb>, StaticOrder<M, NKV>, true, true>(F.lds, F.tid, g, S, E); }
#endif
 }
    }
    else if constexpr (ph == PH_ATT) { p_attn_naive(F); }
    else if constexpr (ph == PH_SCAN) { p_hgrn_scan(F); }
    else if constexpr (ph == PH_COMB) { p_hgrn_combine(F); }
    else if constexpr (ph == PH_OUT) {
        QOut q{wsp<float>(F, WS_Y), F.in[I_X], wsp<float>(F, WS_MU0), wsp<float>(F, WS_RS0), F.in[I_LNG], F.in[I_LNB]};
        if (NAIVE & NV_OUT) naive_gemm(F.lds, F.tid, wsp<bf16_t>(F, WS_MIXA), DM, wsp<bf16_t>(F, WS_WOUT), DM, 0, M, DM, DM, q);
        else { Gemm g{wsp<bf16_t>(F, WS_MIXA), wsp<bf16_t>(F, WS_WOUT), M, DM, DM}; StaticOrder<M, DM> S; S.init(F.G, F.bid); EpiQuad<QOut> E{q}; gemm_phase<DM, EpiQuad<QOut>, StaticOrder<M, DM>, true, true>(F.lds, F.tid, g, S, E); }
    }
    else if constexpr (ph == PH_LN1) { p_ln_pass(F, wsp<float>(F, WS_Y), F.in[I_L1G], F.in[I_L1B], F.out, wsp<bf16_t>(F, WS_H1B)); }
    else if constexpr (ph == PH_UP) {
        if (NAIVE & NV_UP) { QUpNaive q{wsp<bf16_t>(F, WS_UH), 0}; naive_gemm(F.lds, F.tid, wsp<bf16_t>(F, WS_H1B), DM, wsp<bf16_t>(F, WS_WUP), DM, 0, 8192, NUP, DM, q); }
        else { Gemm g{wsp<bf16_t>(F, WS_H1B), wsp<bf16_t>(F, WS_WUP), M, NUP, DM}; StaticOrder<M, NUP> S; S.init(F.G, F.bid);
               EpiConvGlu E{wsp<bf16_t>(F, WS_ACT), wsp<float>(F, WS_HALO), F.in[I_CW], F.in[I_CB], (LAS float*)(F.lds + LDS_BND)}; gemm_phase<DM, EpiConvGlu, StaticOrder<M, NUP>, true, true>(F.lds, F.tid, g, S, E); }
    }
    else if constexpr (ph == PH_GLU0) { if (NAIVE & NV_UP) p_glu_naive(F, 0); }
    else if constexpr (ph == PH_UP1) { if (NAIVE & NV_UP) { QUpNaive q{wsp<bf16_t>(F, WS_UH), 8192}; naive_gemm(F.lds, F.tid, wsp<bf16_t>(F, WS_H1B), DM, wsp<bf16_t>(F, WS_WUP), DM, 8192, 8192, NUP, DM, q); } }
    else if constexpr (ph == PH_GLU1) { if (NAIVE & NV_UP) p_glu_naive(F, 1); }
    else if constexpr (ph == PH_FIX) { if (!(NAIVE & NV_UP) && (NAIVE & NV_DOWN)) { for (int pm = F.bid; pm < 64; pm += F.G) down_fixup(F, pm); } }
    else if constexpr (ph == PH_DOWN) {
        QDown q{wsp<float>(F, WS_Y), F.out};
        if (NAIVE & NV_DOWN) {
            naive_gemm(F.lds, F.tid, wsp<bf16_t>(F, WS_ACT), DFF, wsp<bf16_t>(F, WS_WDN), DFF, 0, M, DM, DFF, q);
        } else { Gemm g{wsp<bf16_t>(F, WS_ACT), wsp<bf16_t>(F, WS_WDN), M, DM, DFF}; StaticOrder<M, DM> S; S.init(F.G, F.bid);
            if (!(NAIVE & NV_UP)) { Unit u; if (S.next(0, u)) down_fixup(F, u.pm); }
            EpiQuad<QDown> E{q}; gemm_phase<DFF, EpiQuad<QDown>, StaticOrder<M, DM>, true, true>(F.lds, F.tid, g, S, E); }
    }
    else if constexpr (ph == PH_LN2) { p_ln_pass(F, wsp<float>(F, WS_Y), F.in[I_L2G], F.in[I_L2B], F.out, nullptr); }
}

__global__ void __launch_bounds__(NTHREADS, 2) mk_fwd(Params p) {
    extern __shared__ __attribute__((aligned(16))) unsigned char lds_raw[];
    Frame F;
    F.lds = (LAS unsigned char*)lds_raw;
    F.tid = threadIdx.x; F.lane = F.tid & 63; F.wave = __builtin_amdgcn_readfirstlane(F.tid >> 6);
    LAS unsigned* MISC = (LAS unsigned*)(F.lds + LDS_MISC);
    if (F.tid < 32) MISC[F.tid] = 0u;
    __syncthreads();
    F.G = gridDim.x; F.bid = blockIdx.x; F.vcu = (F.G % 8 == 0) ? (F.bid % 8) * (F.G / 8) + F.bid / 8 : F.bid;
    F.in = p.in; F.out = p.out; F.ws = p.ws;
#if MK_ONE_LAUNCH
    XcdBarrier xbar = xcd_barrier_post((unsigned*)(p.ws + WS_CTL) + 1024, (volatile LAS unsigned*)(MISC + 8), F.tid);
#endif
#if MK_ONE_LAUNCH
#define GSYNC() do { const int l_ = (int)__builtin_amdgcn_mbcnt_hi(~0u, __builtin_amdgcn_mbcnt_lo(~0u, 0u)); xcd_barrier(xbar, F.wave * 64 + l_, (unsigned)F.G); } while (0)
#else
#define GSYNC() do { } while (0)
#endif
#define PHASE(k) do { if (phase_on(k) && p.ph_lo <= (k) && (k) < p.ph_hi) { run_phase<(k)>(F); if ((k) + 1 < p.ph_hi) GSYNC(); } } while (0)
    PHASE(0); PHASE(1); PHASE(2); PHASE(3); PHASE(4); PHASE(5); PHASE(6); PHASE(7); PHASE(8); PHASE(9); PHASE(10); PHASE(11); PHASE(12); PHASE(13); PHASE(14); PHASE(15);
    static_assert(PH_N == 16, "phase list");
}

extern "C" void kernel_launch(void* const* d_in, const int* in_sizes, int n_in, void* d_out, int out_size, void* d_ws, size_t ws_size, hipStream_t stream) {
    static int grid = 0;
    if (grid == 0) {
        if (n_in != 22 || in_sizes[0] != M * DM || out_size != M * DM || ws_size < WS_END) { fprintf(stderr, "kernel_launch: unexpected shapes (n_in %d, in0 %d, out %d, ws %zu)\n", n_in, n_in > 0 ? in_sizes[0] : -1, out_size, ws_size); grid = -1; return; }
        int dev = 0, cus = 0, per_cu = 0;
        (void)hipGetDevice(&dev); (void)hipDeviceGetAttribute(&cus, hipDeviceAttributeMultiprocessorCount, dev);
        if (hipFuncSetAttribute((const void*)mk_fwd, hipFuncAttributeMaxDynamicSharedMemorySize, LDS_BYTES) != hipSuccess) { fprintf(stderr, "kernel_launch: hipFuncSetAttribute failed\n"); grid = -1; return; }
        (void)hipOccupancyMaxActiveBlocksPerMultiprocessor(&per_cu, (const void*)mk_fwd, NTHREADS, LDS_BYTES);
        if (per_cu < 1) { fprintf(stderr, "kernel_launch: occupancy query says %d blocks per CU\n", per_cu); per_cu = 1; }
        (void)hipGetLastError();
        grid = cus;
    }
    if (grid < 0) return;
    Params p{};
    for (int i = 0; i < 22; ++i) p.in[i] = (const float*)d_in[i];
    p.out = (float*)d_out; p.ws = (unsigned char*)d_ws;
#if MK_ONE_LAUNCH
    p.ph_lo = 0; p.ph_hi = PH_N;
    if (hipMemsetAsync((char*)d_ws + WS_CTL, 0, 65536, stream) != hipSuccess) { fprintf(stderr, "kernel_launch: memset failed\n"); return; }
    void* args[] = {&p};
    hipError_t e = hipLaunchCooperativeKernel((const void*)mk_fwd, dim3(grid), dim3(NTHREADS), args, LDS_BYTES, stream);
    if (e != hipSuccess) fprintf(stderr, "cooperative launch failed: %s (grid %d)\n", hipGetErrorString(e), grid);
#else
    for (int ph = 0; ph < PH_N; ++ph) {
        if (!phase_on(ph)) continue;
        p.ph_lo = ph; p.ph_hi = ph + 1;
        hipLaunchKernelGGL(mk_fwd, dim3(grid), dim3(NTHREADS), LDS_BYTES, stream, p);
    }
#endif
}
```

```cpp
#include <hip/hip_runtime.h>
#include <hip/hip_cooperative_groups.h>
#include <cstdio>
#include <cstdint>
namespace cg = cooperative_groups;

#ifndef MK_ONE_LAUNCH
#define MK_ONE_LAUNCH 1
#endif
#ifndef MK_NAIVE
#define MK_NAIVE 0x00
#endif
constexpr unsigned NAIVE = MK_NAIVE;
constexpr unsigned NV_IN = 1, NV_QKV = 2, NV_ATT = 4, NV_OUT = 8, NV_UP = 16, NV_DOWN = 32;

constexpr int BATCH = 8, SEQ = 2048, DM = 1024, M = BATCH * SEQ;
constexpr int INC = 3136, INCP = 3328;
constexpr int HGW = 512;
constexpr int QRANK = 384, KVRANK = 128, ROPE = 64, NOPE = 128;
constexpr int NQ = 4 * (NOPE + ROPE);
constexpr int NKV = 4 * (NOPE + 128);
constexpr int DFF = 2816, NUP = 2 * DFF;
constexpr float DN_ALPHA = 1.189207115002721f;
constexpr float EPS = 1e-5f;
constexpr float ATT_SCALE = 0.07216878364870322f;

constexpr int PC_Q = 0, PC_V = 512, PC_FF = 1024, PC_FB = 1536, PC_G = 2048, PC_QA = 2560, PC_KVA = 2944, PC_KR = 3072;

constexpr size_t MiB = 1u << 20;
constexpr size_t WS_CTL = 0;
constexpr size_t WS_WIN = 1 * MiB;
constexpr size_t WS_WQB = WS_WIN + (size_t)INCP * DM * 2;
constexpr size_t WS_WKVB = WS_WQB + (size_t)NQ * QRANK * 2;
constexpr size_t WS_WOUT = WS_WKVB + (size_t)NKV * KVRANK * 2;
constexpr size_t WS_WUP = WS_WOUT + (size_t)DM * DM * 2;
constexpr size_t WS_WDN = WS_WUP + (size_t)NUP * DM * 2;
constexpr size_t WS_WEND = WS_WDN + (size_t)DM * DFF * 2;
static_assert(WS_WEND <= 27 * MiB, "weights");
constexpr size_t WS_COS = 27 * MiB, WS_SIN = 29 * MiB;
constexpr size_t WS_MU0 = 31 * MiB, WS_RS0 = WS_MU0 + 65536, WS_LBF = WS_RS0 + 65536, WS_LBB = WS_LBF + 2048;
constexpr size_t WS_SSQQ = WS_LBB + 2048, WS_SSQKV = WS_SSQQ + (size_t)M * 8 * 4;
static_assert(WS_SSQKV + (size_t)M * 4 * 4 <= 32 * MiB, "small");
constexpr size_t WS_XN = 32 * MiB, WS_MIXA = 32 * MiB;
constexpr size_t WS_QHG = 64 * MiB, WS_VHG = 80 * MiB, WS_GATE = 96 * MiB;
constexpr size_t WS_FF = 112 * MiB, WS_FB = 144 * MiB;
constexpr size_t WS_QA = 176 * MiB, WS_KVA = 188 * MiB, WS_KPE = 192 * MiB;
constexpr size_t WS_QAT = 194 * MiB, WS_KV = 218 * MiB;
constexpr size_t WS_Y = 64 * MiB;
constexpr size_t WS_H1B = 128 * MiB;
constexpr size_t WS_ACT = 160 * MiB;
constexpr size_t WS_HALO = 248 * MiB;
constexpr size_t WS_UH = 32 * MiB;
constexpr size_t WS_END = 254 * MiB;
static_assert(WS_HALO + (size_t)64 * 4 * NUP * 4 <= WS_END, "halo");
static_assert(WS_UH + (size_t)8192 * NUP * 2 <= WS_H1B, "uh");

constexpr int LDS_BYTES = 147456;
constexpr int RING_BYTES = 131072;
constexpr int LDS_BND = RING_BYTES;
constexpr int LDS_MISC = RING_BYTES + 8192;
constexpr int NTHREADS = 512;

#define LAS __attribute__((address_space(3)))
typedef unsigned short bf16_t;
typedef short bf16x8 __attribute__((ext_vector_type(8)));
typedef float f32x4 __attribute__((ext_vector_type(4)));
typedef float f32x2 __attribute__((ext_vector_type(2)));
typedef float f32x16 __attribute__((ext_vector_type(16)));
typedef unsigned u32x4 __attribute__((ext_vector_type(4)));
typedef unsigned u32x2 __attribute__((ext_vector_type(2)));
typedef short s16x4 __attribute__((ext_vector_type(4)));

__device__ __forceinline__ float bf2f(bf16_t h) { return __uint_as_float(((unsigned)h) << 16); }
__device__ __forceinline__ unsigned cvt_pk_bf16(float lo, float hi) { unsigned r; asm volatile("v_cvt_pk_bf16_f32 %0, %1, %2" : "=v"(r) : "v"(lo), "v"(hi)); return r; }
__device__ __forceinline__ float sigmoidf_(float x) { return 1.0f / (1.0f + __expf(-x)); }
__device__ __forceinline__ float siluf_(float x) { return x * sigmoidf_(x); }
__device__ __forceinline__ float gelu_tanh(float x) {
    const float z = 1.5957691216057308f * (x + 0.044715f * x * x * x);
    return x / (1.0f + __expf(-z));
}
__device__ __forceinline__ float wave_sum(float v) {
#pragma unroll
    for (int o = 1; o < 64; o <<= 1) v += __shfl_xor(v, o);
    return v;
}
__device__ __forceinline__ float wave_max(float v) {
#pragma unroll
    for (int o = 1; o < 64; o <<= 1) v = fmaxf(v, __shfl_xor(v, o));
    return v;
}

struct Params {
    const float* in[22];
    float* out;
    unsigned char* ws;
    int ph_lo, ph_hi;
};
enum { I_X = 0, I_POS, I_LNG, I_LNB, I_WIN, I_LBF, I_LBB, I_HGG, I_QAG, I_WQB, I_KVG, I_WKVB, I_ATG, I_WOUT, I_L1G, I_L1B, I_WUP, I_CW, I_CB, I_WDN, I_L2G, I_L2B };

struct RowP { float a, b; };

namespace pg8 {
constexpr int BM = 256, BK = 64, HALF = 128, HTB = HALF * BK * 2, STAGE_BYTES = 8 * HTB, NXCD = 8, WGM = 8;
__host__ __device__ __forceinline__ int lds_byte(int r, int c) { const int st = (r >> 4) * 2 + (c >> 5), rr = r & 15, cc = c & 31, ob = rr * 64 + cc * 2; return st * 1024 + (ob ^ (((ob >> 9) & 1) << 5)); }
__host__ __device__ __forceinline__ void stage_rc(int b, int& R, int& C) { const int st = b / 1024, sb = b % 1024, swz = sb ^ (((sb >> 9) & 1) << 5); R = (st >> 1) * 16 + swz / 64; C = (st & 1) * 32 + (swz % 64) / 2; }
__host__ __device__ __forceinline__ int perm32(int rho) { const int n = rho >> 4, i = rho & 15; return 8 * (i >> 2) + 4 * n + (i & 3); }

struct Unit { int pm, pn; };
struct Gemm { const bf16_t* A; const bf16_t* Bt; int M, N, K; };

template <int MM, int NN> struct StaticOrder {
    static constexpr int nM = MM / BM, nN = NN / BM, nwg = nM * nN; int G, c;
    __host__ __device__ void init(int G_, int c_) { G = G_; c = c_; }
    __host__ __device__ bool next(int i, Unit& u) const {
        const long L = (long)i * G + c; if (L >= nwg) return false;
        int wgid = (int)L; { const int q = nwg / NXCD, r = nwg % NXCD, xcd = wgid % NXCD, off = wgid / NXCD; wgid = (xcd < r ? xcd * (q + 1) : r * (q + 1) + (xcd - r) * q) + off; }
        const int nig = WGM * nN, gid = wgid / nig, fm = gid * WGM, gsz = (nM - fm) < WGM ? (nM - fm) : WGM;
        u.pm = fm + ((wgid % nig) % gsz); u.pn = (wgid % nig) / gsz; return true;
    }
    __device__ __forceinline__ void a_ready(const Unit&) const {}
    __device__ __forceinline__ void done(const Unit&) const {}
};

template <int KK, class Epi, class Sched, bool ALIGN_EPI = false, bool SP2 = false>
__device__ __forceinline__ void gemm_phase(LAS unsigned char* lds, int tid_in, const Gemm g, const Sched& S, const Epi& E) {
    const int tid = tid_in, wid = __builtin_amdgcn_readfirstlane(tid >> 6), lane = tid & 63, wr = wid >> 2, wc = wid & 3, fr = lane & 15, fq = lane >> 4;
    constexpr int K = KK, nt = K / BK;
    unsigned voffA[2], voffB[2];
#pragma unroll
    for (int i = 0; i < 2; ++i) { int R, C; stage_rc(tid * 16 + i * 8192, R, C); const int Rb = Epi::PERM ? ((R & ~31) + perm32(R & 31)) : R;
        voffA[i] = (unsigned)(R * K + C) * 2u; voffB[i] = (unsigned)(Rb * K + C) * 2u; }
    constexpr size_t kstep = (size_t)(BK * 2);
    constexpr size_t hstep = (size_t)HALF * K * 2;
    constexpr size_t tstep = 2 * hstep;
    const unsigned ldsw = (unsigned)wid * 1024u;
    const int aoff = lds_byte(wr * 64 + fr, fq * 8), boff = lds_byte(wc * 32 + fr, fq * 8);
#define PG8_SA(b, h) (((b) * 2 + (h)) * HTB)
#define PG8_SB(b, h) ((4 + (b) * 2 + (h)) * HTB)
#define PG8_STAGE(bufoff, gbase, voff) do { _Pragma("unroll") for (int _i = 0; _i < 2; ++_i) \
        __builtin_amdgcn_global_load_lds((const unsigned*)((const char*)(gbase) + (voff)[_i]), (LAS unsigned*)(lds + (bufoff) + ldsw + _i * 8192), 16, 0, 0); } while (0)
#define PG8_LDA(dst, b, h) do { _Pragma("unroll") for (int m = 0; m < 4; ++m) _Pragma("unroll") for (int k = 0; k < 2; ++k) dst[m][k] = *(const LAS bf16x8*)(lds + PG8_SA(b, h) + aoff + m * 2048 + k * 1024); } while (0)
#define PG8_LDB(dst, b, h) do { _Pragma("unroll") for (int n = 0; n < 2; ++n) _Pragma("unroll") for (int k = 0; k < 2; ++k) dst[n][k] = *(const LAS bf16x8*)(lds + PG8_SB(b, h) + boff + n * 2048 + k * 1024); } while (0)
#define PG8_MMA(ai, bj, At, Bt) do { __builtin_amdgcn_s_setprio(1); _Pragma("unroll") for (int m = 0; m < 4; ++m) _Pragma("unroll") for (int n = 0; n < 2; ++n) _Pragma("unroll") for (int k = 0; k < 2; ++k) \
        acc[ai][bj][m][n] = __builtin_amdgcn_mfma_f32_16x16x32_bf16(Bt[n][k], At[m][k], acc[ai][bj][m][n], 0, 0, 0); __builtin_amdgcn_s_setprio(0); } while (0)
#define PG8_WAIT_V(n) asm volatile("s_waitcnt vmcnt(" #n ")" ::: "memory")
#define PG8_WAIT_L(n) asm volatile("s_waitcnt lgkmcnt(" #n ")" ::: "memory")
#define PG8_BAR __builtin_amdgcn_s_barrier()
#define PG8_SCHED __builtin_amdgcn_sched_barrier(0)
    Unit cur, nxt; int ui = 0;
    if (!S.next(0, cur)) return;
    f32x4 acc[2][2][4][2];
#pragma unroll
    for (int a = 0; a < 2; ++a)
#pragma unroll
        for (int b = 0; b < 2; ++b)
#pragma unroll
            for (int m = 0; m < 4; ++m)
#pragma unroll
                for (int n = 0; n < 2; ++n) acc[a][b][m][n] = (f32x4){0.f, 0.f, 0.f, 0.f};
    bf16x8 At[4][2], B0[2][2], B1[2][2];
    const char* cA = (const char*)g.A + (size_t)cur.pm * tstep; const char* cB = (const char*)g.Bt + (size_t)cur.pn * tstep;
    S.a_ready(cur);
    if constexpr (SP2) {
        PG8_STAGE(PG8_SB(0, 0), cB, voffB); PG8_STAGE(PG8_SB(0, 1), cB + hstep, voffB); PG8_STAGE(PG8_SA(0, 0), cA, voffA); PG8_STAGE(PG8_SA(0, 1), cA + hstep, voffA);
        if (wr == 1) PG8_BAR;
        PG8_WAIT_V(2); PG8_BAR;
        PG8_STAGE(PG8_SB(1, 0), cB + kstep, voffB); PG8_STAGE(PG8_SA(1, 0), cA + kstep, voffA); PG8_STAGE(PG8_SB(1, 1), cB + hstep + kstep, voffB);
        PG8_WAIT_V(6); PG8_BAR;
    } else {
        PG8_STAGE(PG8_SB(0, 0), cB, voffB); PG8_STAGE(PG8_SA(0, 0), cA, voffA); PG8_STAGE(PG8_SB(0, 1), cB + hstep, voffB); PG8_STAGE(PG8_SA(0, 1), cA + hstep, voffA);
        if (wr == 1) PG8_BAR;
        PG8_WAIT_V(4); PG8_BAR;
        PG8_STAGE(PG8_SB(1, 0), cB + kstep, voffB); PG8_STAGE(PG8_SA(1, 0), cA + kstep, voffA); PG8_STAGE(PG8_SB(1, 1), cB + hstep + kstep, voffB);
        PG8_WAIT_V(6); PG8_BAR;
    }
    for (;;) {
        const bool has_next = S.next(ui + 1, nxt);
        const char* nA = has_next ? (const char*)g.A + (size_t)nxt.pm * tstep : cA; const char* nB = has_next ? (const char*)g.Bt + (size_t)nxt.pn * tstep : cB;
#pragma unroll 1
        for (int t = 0; t < nt; t += 2) {
            const bool last = (t == nt - 2);
            const char* a1 = cA + (size_t)(t + 1) * kstep;
            const char* a2 = last ? nA : cA + (size_t)(t + 2) * kstep; const char* b2 = last ? nB : cB + (size_t)(t + 2) * kstep;
            const char* a3 = a2 + kstep; const char* b3 = b2 + kstep;
            if (last && has_next) S.a_ready(nxt);
            if constexpr (SP2) {
            PG8_LDB(B0, 0, 0); PG8_LDB(B1, 0, 1); PG8_SCHED; PG8_LDA(At, 0, 0); PG8_STAGE(PG8_SA(1, 1), a1 + hstep, voffA);
            PG8_WAIT_V(8); PG8_WAIT_L(0); PG8_BAR; PG8_MMA(0, 0, At, B0); PG8_MMA(0, 1, At, B1); PG8_BAR; PG8_SCHED;
            PG8_LDA(At, 0, 1); PG8_STAGE(PG8_SB(0, 0), b2, voffB); PG8_STAGE(PG8_SB(0, 1), b2 + hstep, voffB); PG8_STAGE(PG8_SA(0, 0), a2, voffA);
            PG8_WAIT_V(8); PG8_WAIT_L(0); PG8_BAR; PG8_MMA(1, 0, At, B0); PG8_MMA(1, 1, At, B1); PG8_BAR; PG8_SCHED;
            PG8_LDB(B0, 1, 0); PG8_LDB(B1, 1, 1); PG8_SCHED; PG8_LDA(At, 1, 0); PG8_STAGE(PG8_SA(0, 1), a2 + hstep, voffA);
            PG8_WAIT_V(8); PG8_WAIT_L(0); PG8_BAR; PG8_MMA(0, 0, At, B0); PG8_MMA(0, 1, At, B1); PG8_BAR; PG8_SCHED;
            PG8_LDA(At, 1, 1); PG8_STAGE(PG8_SB(1, 0), b3, voffB); PG8_STAGE(PG8_SB(1, 1), b3 + hstep, voffB); PG8_STAGE(PG8_SA(1, 0), a3, voffA);
            PG8_WAIT_V(8); PG8_WAIT_L(0); PG8_BAR; PG8_MMA(1, 0, At, B0); PG8_MMA(1, 1, At, B1); PG8_BAR; PG8_SCHED;
            } else {
            PG8_LDB(B0, 0, 0); PG8_SCHED; PG8_LDA(At, 0, 0); PG8_STAGE(PG8_SA(1, 1), a1 + hstep, voffA);
            PG8_WAIT_L(8); PG8_BAR; PG8_WAIT_L(0); PG8_MMA(0, 0, At, B0); PG8_BAR; PG8_SCHED;
            PG8_LDB(B1, 0, 1); PG8_STAGE(PG8_SB(0, 0), b2, voffB);
            PG8_BAR; PG8_WAIT_L(0); PG8_MMA(0, 1, At, B1); PG8_BAR;
            PG8_LDA(At, 0, 1); PG8_STAGE(PG8_SA(0, 0), a2, voffA);
            PG8_BAR; PG8_WAIT_L(0); PG8_MMA(1, 0, At, B0); PG8_BAR; PG8_SCHED;
            PG8_STAGE(PG8_SB(0, 1), b2 + hstep, voffB);
            PG8_WAIT_V(6); PG8_BAR; PG8_MMA(1, 1, At, B1); PG8_BAR;
            PG8_LDB(B0, 1, 0); PG8_SCHED; PG8_LDA(At, 1, 0); PG8_STAGE(PG8_SA(0, 1), a2 + hstep, voffA);
            PG8_WAIT_L(8); PG8_BAR; PG8_WAIT_L(0); PG8_MMA(0, 0, At, B0); PG8_BAR; PG8_SCHED;
            PG8_LDB(B1, 1, 1); PG8_STAGE(PG8_SB(1, 0), b3, voffB);
            PG8_BAR; PG8_WAIT_L(0); PG8_MMA(0, 1, At, B1); PG8_BAR;
            PG8_LDA(At, 1, 1); PG8_STAGE(PG8_SA(1, 0), a3, voffA);
            PG8_BAR; PG8_WAIT_L(0); PG8_MMA(1, 0, At, B0); PG8_BAR; PG8_SCHED;
            PG8_STAGE(PG8_SB(1, 1), b3 + hstep, voffB);
            PG8_WAIT_V(6); PG8_BAR; PG8_MMA(1, 1, At, B1); PG8_BAR;
            }
        }
        if constexpr (ALIGN_EPI) { if (wr == 0) PG8_BAR; }
        if constexpr (!Epi::AFTER_DRAIN) { E(acc, cur, wr, wc, fr, fq); S.done(cur); }
        if (!has_next) break;
#pragma unroll
        for (int a = 0; a < 2; ++a)
#pragma unroll
            for (int b = 0; b < 2; ++b)
#pragma unroll
                for (int m = 0; m < 4; ++m)
#pragma unroll
                    for (int n = 0; n < 2; ++n) acc[a][b][m][n] = (f32x4){0.f, 0.f, 0.f, 0.f};
        cur = nxt; cA = nA; cB = nB; ++ui;
        if constexpr (ALIGN_EPI) { if (wr == 1) PG8_BAR; }
    }
    PG8_WAIT_V(0);
    if constexpr (!ALIGN_EPI) { if (wr == 0) PG8_BAR; }
    PG8_BAR;
    if constexpr (Epi::AFTER_DRAIN) { E.fused(acc, cur, wr, wc, fr, fq, lds, wid, lane); S.done(cur); }
#undef PG8_SA
#undef PG8_SB
#undef PG8_STAGE
#undef PG8_LDA
#undef PG8_LDB
#undef PG8_MMA
#undef PG8_WAIT_V
#undef PG8_WAIT_L
#undef PG8_BAR
#undef PG8_SCHED
}

template <class Q> struct EpiQuad {
    static constexpr bool PERM = false, AFTER_DRAIN = false; Q q;
    __device__ __forceinline__ void operator()(const f32x4 (&acc)[2][2][4][2], const Unit& u, int wr, int wc, int fr, int fq) const {
#pragma unroll
        for (int ai = 0; ai < 2; ++ai)
#pragma unroll
            for (int m = 0; m < 4; ++m) { const int r = u.pm * BM + ai * HALF + wr * 64 + m * 16 + fr; const RowP rp = q.row_prep(r);
#pragma unroll
                for (int bj = 0; bj < 2; ++bj)
#pragma unroll
                    for (int n = 0; n < 2; ++n) q.quad(r, u.pn * BM + bj * HALF + wc * 32 + n * 16 + fq * 4, acc[ai][bj][m][n], rp);
                asm volatile("" ::: "memory"); }
    }
};
}

__device__ __forceinline__ void st_bf16x4(bf16_t* p, f32x4 v) { u32x2 w; w.x = cvt_pk_bf16(v[0], v[1]); w.y = cvt_pk_bf16(v[2], v[3]); *(u32x2*)p = w; }
__device__ __forceinline__ f32x4 rope4(f32x4 v, const float* cosr, const float* sinr, int i0) {
    const float c0 = cosr[i0], s0 = sinr[i0], c1 = cosr[i0 + 1], s1 = sinr[i0 + 1];
    return (f32x4){v[0] * c0 - v[1] * s0, v[1] * c0 + v[0] * s0, v[2] * c1 - v[3] * s1, v[3] * c1 + v[2] * s1};
}

struct QInProj {
    bf16_t *QHG, *VHG, *GATE, *QA, *KVA, *KPE; float *FF, *FB; const float *LBF, *LBB, *COS, *SIN;
    __device__ __forceinline__ RowP row_prep(int) const { return RowP{0.f, 0.f}; }
    __device__ __forceinline__ void quad(int r, int c, f32x4 v, RowP) const {
        if (c < PC_V) { st_bf16x4(QHG + (size_t)r * HGW + c, (f32x4){siluf_(v[0]), siluf_(v[1]), siluf_(v[2]), siluf_(v[3])}); }
        else if (c < PC_FF) { st_bf16x4(VHG + (size_t)r * HGW + (c - PC_V), v); }
        else if (c < PC_G) { const bool fw = c < PC_FB; const int cc = c - (fw ? PC_FF : PC_FB); const f32x4 lb = *(const f32x4*)((fw ? LBF : LBB) + cc);
            f32x4 f;
#pragma unroll
            for (int j = 0; j < 4; ++j) f[j] = lb[j] + (1.0f - lb[j]) * sigmoidf_(v[j]);
            *(f32x4*)((fw ? FF : FB) + (size_t)r * HGW + cc) = f; }
        else if (c < PC_QA) { st_bf16x4(GATE + (size_t)r * HGW + (c - PC_G), (f32x4){siluf_(v[0]), siluf_(v[1]), siluf_(v[2]), siluf_(v[3])}); }
        else if (c < PC_KVA) { st_bf16x4(QA + (size_t)r * QRANK + (c - PC_QA), v); }
        else if (c < PC_KR) { st_bf16x4(KVA + (size_t)r * KVRANK + (c - PC_KVA), v); }
        else if (c < INC) { const int e = c - PC_KR; st_bf16x4(KPE + (size_t)r * ROPE + e, rope4(v, COS + (size_t)r * 32, SIN + (size_t)r * 32, e >> 1)); }
    }
};
struct QQb {
    bf16_t* QAT; const float *SSQQ, *COS, *SIN;
    __device__ __forceinline__ RowP row_prep(int r) const { const f32x4 a = *(const f32x4*)(SSQQ + (size_t)r * 8), b = *(const f32x4*)(SSQQ + (size_t)r * 8 + 4);
        const float s = ((a[0] + a[1]) + (a[2] + a[3])) + ((b[0] + b[1]) + (b[2] + b[3])); return RowP{1.0f / sqrtf(s * (1.0f / QRANK) + EPS), 0.f}; }
    __device__ __forceinline__ void quad(int r, int c, f32x4 v, RowP rp) const {
        v = v * rp.a; const int d = c % 192;
        if (d >= NOPE) v = rope4(v, COS + (size_t)r * 32, SIN + (size_t)r * 32, (d - NOPE) >> 1);
        st_bf16x4(QAT + (size_t)r * NQ + c, v);
    }
};
struct QKvb {
    bf16_t* KV; const float* SSQKV;
    __device__ __forceinline__ RowP row_prep(int r) const { const f32x4 a = *(const f32x4*)(SSQKV + (size_t)r * 4);
        return RowP{1.0f / sqrtf(((a[0] + a[1]) + (a[2] + a[3])) * (1.0f / KVRANK) + EPS), 0.f}; }
    __device__ __forceinline__ void quad(int r, int c, f32x4 v, RowP rp) const { st_bf16x4(KV + (size_t)r * NKV + c, v * rp.a); }
};
struct QOut {
    float* Y; const float *X, *MU0, *RS0, *G, *Bv;
    __device__ __forceinline__ RowP row_prep(int r) const { return RowP{MU0[r], RS0[r]}; }
    __device__ __forceinline__ void quad(int r, int c, f32x4 v, RowP rp) const {
        const f32x4 x = *(const f32x4*)(X + (size_t)r * DM + c), g = *(const f32x4*)(G + c), b = *(const f32x4*)(Bv + c);
        const f32x4 h0 = (x - rp.a) * rp.b * g + b;
        *(f32x4*)(Y + (size_t)r * DM + c) = h0 * DN_ALPHA + v;
    }
};
struct QUpNaive {
    bf16_t* UH; int r0;
    __device__ __forceinline__ RowP row_prep(int) const { return RowP{0.f, 0.f}; }
    __device__ __forceinline__ void quad(int r, int c, f32x4 v, RowP) const { st_bf16x4(UH + (size_t)(r - r0) * NUP + c, v); }
};
struct QDown {
    float* Y; const float* H1;
    __device__ __forceinline__ RowP row_prep(int) const { return RowP{0.f, 0.f}; }
    __device__ __forceinline__ void quad(int r, int c, f32x4 v, RowP) const {
        const f32x4 h = *(const f32x4*)(H1 + (size_t)r * DM + c);
        *(f32x4*)(Y + (size_t)r * DM + c) = h * DN_ALPHA + v;
    }
};

struct EpiInProj {
    static constexpr bool PERM = false, AFTER_DRAIN = false; QInProj q; float *SSQQ, *SSQKV;
    __device__ __forceinline__ void operator()(const f32x4 (&acc)[2][2][4][2], const pg8::Unit& u, int wr, int wc, int fr, int fq) const {
        pg8::EpiQuad<QInProj> e{q}; e(acc, u, wr, wc, fr, fq);
        if (u.pn == 10 || u.pn == 11) {
#pragma unroll
            for (int ai = 0; ai < 2; ++ai)
#pragma unroll
                for (int m = 0; m < 4; ++m) { const int r = u.pm * 256 + ai * 128 + wr * 64 + m * 16 + fr; float s[2];
#pragma unroll
                    for (int bj = 0; bj < 2; ++bj) { float t = 0.f;
#pragma unroll
                        for (int n = 0; n < 2; ++n) { const f32x4 x = acc[ai][bj][m][n]; t += (x[0] * x[0] + x[1] * x[1]) + (x[2] * x[2] + x[3] * x[3]); }
                        t += __shfl_xor(t, 16); t += __shfl_xor(t, 32); s[bj] = t; }
                    if (fq == 0) { if (u.pn == 10) SSQQ[(size_t)r * 8 + wc] = s[0] + s[1]; else { SSQQ[(size_t)r * 8 + 4 + wc] = s[0]; SSQKV[(size_t)r * 4 + wc] = s[1]; } } }
        }
    }
};

__device__ __forceinline__ float dpp_ror1(float x) { return __int_as_float(__builtin_amdgcn_update_dpp(0, __float_as_int(x), 0x121, 0xF, 0xF, false)); }
__device__ __forceinline__ float dpp_rol1(float x) { return __int_as_float(__builtin_amdgcn_update_dpp(0, __float_as_int(x), 0x12F, 0xF, 0xF, false)); }
struct EpiConvGlu {
    static constexpr bool PERM = true, AFTER_DRAIN = false;
    bf16_t* ACT; float* HALO; const float* CW; const float* CBv; LAS float* bnd;
    __device__ __forceinline__ void operator()(const f32x4 (&acc)[2][2][4][2], const pg8::Unit& u, int wr, int wc, int fr, int fq) const {
        const int chl = wc * 32 + fq * 8;
#pragma unroll
        for (int ai = 0; ai < 2; ++ai) { const int gq = 2 * ai + wr;
            if (fr == 0) {
#pragma unroll
                for (int bj = 0; bj < 2; ++bj)
#pragma unroll
                    for (int n = 0; n < 2; ++n) *(LAS f32x4*)(bnd + ((gq * 2 + 0) * 2 + bj) * 128 + chl + 4 * n) = acc[ai][bj][0][n]; }
            if (fr == 15) {
#pragma unroll
                for (int bj = 0; bj < 2; ++bj)
#pragma unroll
                    for (int n = 0; n < 2; ++n) *(LAS f32x4*)(bnd + ((gq * 2 + 1) * 2 + bj) * 128 + chl + 4 * n) = acc[ai][bj][3][n]; } }
        if (wr == 0 && fr < 2) {
#pragma unroll
            for (int bj = 0; bj < 2; ++bj)
#pragma unroll
                for (int n = 0; n < 2; ++n) *(f32x4*)(HALO + ((size_t)u.pm * 4 + fr) * NUP + bj * DFF + u.pn * 128 + chl + 4 * n) = acc[0][bj][0][n]; }
        if (wr == 1 && fr >= 14) {
#pragma unroll
            for (int bj = 0; bj < 2; ++bj)
#pragma unroll
                for (int n = 0; n < 2; ++n) *(f32x4*)(HALO + ((size_t)u.pm * 4 + (fr - 12)) * NUP + bj * DFF + u.pn * 128 + chl + 4 * n) = acc[1][bj][3][n]; }
        asm volatile("s_waitcnt lgkmcnt(0)" ::: "memory"); __builtin_amdgcn_s_barrier(); asm volatile("" ::: "memory");
        unsigned outw[2][4][4];
#pragma unroll
        for (int ai = 0; ai < 2; ++ai) { const int gq = 2 * ai + wr;
#pragma unroll
          for (int n = 0; n < 2; ++n)
#pragma unroll
            for (int jp = 0; jp < 2; ++jp) {
                float val[2][4];
#pragma unroll
                for (int jj = 0; jj < 2; ++jj) { const int j = 2 * jp + jj, cl = chl + 4 * n + j, ch = u.pn * 128 + cl;
                    const float wa0 = CW[ch], wa1 = CW[NUP + ch], wa2 = CW[2 * NUP + ch], ba = CBv[ch];
                    const float wb0 = CW[DFF + ch], wb1 = CW[NUP + DFF + ch], wb2 = CW[2 * NUP + DFF + ch], bb = CBv[DFF + ch];
                    const float pbA = gq > 0 ? bnd[(((gq - 1) * 2 + 1) * 2 + 0) * 128 + cl] : 0.f, pbB = gq > 0 ? bnd[(((gq - 1) * 2 + 1) * 2 + 1) * 128 + cl] : 0.f;
                    const float nbA = gq < 3 ? bnd[(((gq + 1) * 2 + 0) * 2 + 0) * 128 + cl] : 0.f, nbB = gq < 3 ? bnd[(((gq + 1) * 2 + 0) * 2 + 1) * 128 + cl] : 0.f;
                    float xa[4], xb[4], Ra[4], La[4], Rb[4], Lb[4];
#pragma unroll
                    for (int m = 0; m < 4; ++m) { xa[m] = acc[ai][0][m][n][j]; xb[m] = acc[ai][1][m][n][j]; Ra[m] = dpp_ror1(xa[m]); La[m] = dpp_rol1(xa[m]); Rb[m] = dpp_ror1(xb[m]); Lb[m] = dpp_rol1(xb[m]); }
#pragma unroll
                    for (int m = 0; m < 4; ++m) {
                        const float pa = fr > 0 ? Ra[m] : (m > 0 ? Ra[m > 0 ? m - 1 : 0] : pbA), pb = fr > 0 ? Rb[m] : (m > 0 ? Rb[m > 0 ? m - 1 : 0] : pbB);
                        const float na = fr < 15 ? La[m] : (m < 3 ? La[m < 3 ? m + 1 : 3] : nbA), nb = fr < 15 ? Lb[m] : (m < 3 ? Lb[m < 3 ? m + 1 : 3] : nbB);
                        const float ca = wa0 * pa + wa1 * xa[m] + wa2 * na + ba, cb = wb0 * pb + wb1 * xb[m] + wb2 * nb + bb;
                        val[jj][m] = gelu_tanh(ca) * cb; } }
#pragma unroll
                for (int m = 0; m < 4; ++m) outw[ai][m][n * 2 + jp] = cvt_pk_bf16(val[0][m], val[1][m]);
            } }
#pragma unroll
        for (int ai = 0; ai < 2; ++ai)
#pragma unroll
            for (int m = 0; m < 4; ++m) { const int tr = ai * 128 + wr * 64 + m * 16 + fr;
                if (tr != 0 && tr != 255) *(u32x4*)(ACT + (size_t)(u.pm * 256 + tr) * DFF + u.pn * 128 + chl) = (u32x4){outw[ai][m][0], outw[ai][m][1], outw[ai][m][2], outw[ai][m][3]}; }
    }
};

template <class Q>
__device__ __forceinline__ void naive_gemm(LAS unsigned char* lds, int tid, const bf16_t* A, int lda, const bf16_t* Bt, int ldb, int row0, int nrows, int N, int K, const Q& q) {
    LAS float* As = (LAS float*)lds;
    LAS float* Bs = As + 16 * 132;
    const int ty = tid >> 4, tx = tid & 15;
    const int tiles_n = N / 64, ntiles = (nrows / 128) * tiles_n;
    for (int t = blockIdx.x; t < ntiles; t += gridDim.x) {
        const int tm = t / tiles_n, tn = t % tiles_n;
        float acc[4][4];
#pragma unroll
        for (int i = 0; i < 4; ++i)
#pragma unroll
            for (int j = 0; j < 4; ++j) acc[i][j] = 0.f;
        for (int k0 = 0; k0 < K; k0 += 16) {
            { const int row = tid >> 2, kk = (tid & 3) * 4; const ushort4 v = *(const ushort4*)(A + (size_t)(row0 + tm * 128 + row) * lda + k0 + kk);
              As[(kk + 0) * 132 + row] = bf2f(v.x); As[(kk + 1) * 132 + row] = bf2f(v.y); As[(kk + 2) * 132 + row] = bf2f(v.z); As[(kk + 3) * 132 + row] = bf2f(v.w); }
            if (tid < 256) { const int n = tid >> 2, kk = (tid & 3) * 4; const ushort4 v = *(const ushort4*)(Bt + (size_t)(tn * 64 + n) * ldb + k0 + kk);
              Bs[(kk + 0) * 68 + n] = bf2f(v.x); Bs[(kk + 1) * 68 + n] = bf2f(v.y); Bs[(kk + 2) * 68 + n] = bf2f(v.z); Bs[(kk + 3) * 68 + n] = bf2f(v.w); }
            __syncthreads();
#pragma unroll
            for (int kk = 0; kk < 16; ++kk) {
                const f32x4 a = *(const LAS f32x4*)(As + kk * 132 + ty * 4), b = *(const LAS f32x4*)(Bs + kk * 68 + tx * 4);
#pragma unroll
                for (int i = 0; i < 4; ++i)
#pragma unroll
                    for (int j = 0; j < 4; ++j) acc[i][j] = fmaf(a[i], b[j], acc[i][j]);
            }
            __syncthreads();
        }
#pragma unroll
        for (int i = 0; i < 4; ++i) { const int r = row0 + tm * 128 + ty * 4 + i; const RowP rp = q.row_prep(r); q.quad(r, tn * 64 + tx * 4, (f32x4){acc[i][0], acc[i][1], acc[i][2], acc[i][3]}, rp); }
    }
}

struct Frame {
    LAS unsigned char* lds; int tid, lane, wave, G, bid, vcu;
    const float* const* in; float* out; unsigned char* ws;
};
template <class T> __device__ __forceinline__ T* wsp(const Frame& F, size_t off) { return (T*)(F.ws + off); }

template <class PhysFn>
__device__ __forceinline__ void transpose_item(const float* W, int K, int N, bf16_t* WT, const float* kscale, LAS float* scr, int item, int lane, PhysFn phys) {
    const int nblk = N / 32, kb = item / nblk, nb = item % nblk, k0 = 64 * kb, n0 = 32 * nb;
#pragma unroll 8
    for (int i = 0; i < 32; ++i) { const int kk = 2 * i + (lane >> 5); float w = W[(size_t)(k0 + kk) * N + n0 + (lane & 31)]; if (kscale) w *= kscale[k0 + kk]; scr[kk * 33 + (lane & 31)] = w; }
    asm volatile("s_waitcnt lgkmcnt(0)" ::: "memory");
    const int c = lane & 7;
#pragma unroll
    for (int j = 0; j < 4; ++j) { const int n = (lane >> 3) + 8 * j; const LAS float* s = scr + (8 * c) * 33 + n;
        u32x4 o; o.x = cvt_pk_bf16(s[0 * 33], s[1 * 33]); o.y = cvt_pk_bf16(s[2 * 33], s[3 * 33]); o.z = cvt_pk_bf16(s[4 * 33], s[5 * 33]); o.w = cvt_pk_bf16(s[6 * 33], s[7 * 33]);
        *(u32x4*)(WT + (size_t)phys(n0 + n) * K + k0 + 8 * c) = o; }
    asm volatile("s_waitcnt lgkmcnt(0)" ::: "memory");
}
__device__ __forceinline__ int phys_id(int n) { return n; }
__device__ __forceinline__ int phys_rope64(int e) { return e < 32 ? 2 * e : 2 * (e - 32) + 1; }
__device__ __forceinline__ int phys_win(int n) { return n < PC_KR ? n : PC_KR + phys_rope64(n - PC_KR); }
__device__ __forceinline__ int phys_wqb(int n) { const int h = n / 192, d = n % 192; return h * 192 + (d < NOPE ? d : NOPE + phys_rope64(d - NOPE)); }
__device__ __forceinline__ int phys_wup(int n) { const int j = n < DFF ? n : n - DFF; return (j >> 7) * 256 + (n < DFF ? 0 : 128) + (j & 127); }

__device__ __forceinline__ void p0_prologue(Frame& F) {
    LAS float* scr = (LAS float*)(F.lds + F.wave * 16384);
    const int gw = F.vcu * 8 + F.wave, NGW = F.G * 8;
    bf16_t* WIN = wsp<bf16_t>(F, WS_WIN); bf16_t* WQB = wsp<bf16_t>(F, WS_WQB); bf16_t* WKVB = wsp<bf16_t>(F, WS_WKVB);
    bf16_t* WOUT = wsp<bf16_t>(F, WS_WOUT); bf16_t* WUP = wsp<bf16_t>(F, WS_WUP); bf16_t* WDN = wsp<bf16_t>(F, WS_WDN);
    constexpr int I_IN = (DM / 64) * (INC / 32), I_QB = (QRANK / 64) * (NQ / 32), I_KVB = (KVRANK / 64) * (NKV / 32), I_OUT = (DM / 64) * (DM / 32), I_UP = (DM / 64) * (NUP / 32), I_DN = (DFF / 64) * (DM / 32);
    constexpr int NITEMS = I_IN + I_QB + I_KVB + I_OUT + I_UP + I_DN;
    for (int it = gw; it < NITEMS; it += NGW) {
        int r = it;
        if (r < I_IN) { transpose_item(F.in[I_WIN], DM, INC, WIN, nullptr, scr, r, F.lane, phys_win); continue; } r -= I_IN;
        if (r < I_QB) { transpose_item(F.in[I_WQB], QRANK, NQ, WQB, F.in[I_QAG], scr, r, F.lane, phys_wqb); continue; } r -= I_QB;
        if (r < I_KVB) { transpose_item(F.in[I_WKVB], KVRANK, NKV, WKVB, F.in[I_KVG], scr, r, F.lane, phys_id); continue; } r -= I_KVB;
        if (r < I_OUT) { transpose_item(F.in[I_WOUT], DM, DM, WOUT, nullptr, scr, r, F.lane, phys_id); continue; } r -= I_OUT;
        if (r < I_UP) { transpose_item(F.in[I_WUP], DM, NUP, WUP, nullptr, scr, r, F.lane, phys_wup); continue; } r -= I_UP;
        transpose_item(F.in[I_WDN], DFF, DM, WDN, nullptr, scr, r, F.lane, phys_id);
    }
    { u32x4* z = (u32x4*)(WIN + (size_t)INC * DM); const int n16 = (INCP - INC) * DM * 2 / 16;
      for (int i = F.bid * NTHREADS + F.tid; i < n16; i += F.G * NTHREADS) z[i] = (u32x4){0u, 0u, 0u, 0u}; }
    { bf16_t* XN = wsp<bf16_t>(F, WS_XN); float* MU0 = wsp<float>(F, WS_MU0); float* RS0 = wsp<float>(F, WS_RS0);
      const float* g = F.in[I_LNG]; const float* bb = F.in[I_LNB];
      for (int m = gw; m < M; m += NGW) {
        const f32x4* xr = (const f32x4*)(F.in[I_X] + (size_t)m * DM) + F.lane;
        f32x4 v[4]; float s = 0.f;
#pragma unroll
        for (int j = 0; j < 4; ++j) { v[j] = xr[64 * j]; s += (v[j][0] + v[j][1]) + (v[j][2] + v[j][3]); }
        const float mean = wave_sum(s) * (1.f / DM); float s2 = 0.f;
#pragma unroll
        for (int j = 0; j < 4; ++j) { const f32x4 d = v[j] - mean; s2 += (d[0] * d[0] + d[1] * d[1]) + (d[2] * d[2] + d[3] * d[3]); }
        const float rstd = 1.f / sqrtf(wave_sum(s2) * (1.f / DM) + EPS);
        if (F.lane == 0) { MU0[m] = mean; RS0[m] = rstd; }
#pragma unroll
        for (int j = 0; j < 4; ++j) { const int c = 4 * F.lane + 256 * j; const f32x4 gg = *(const f32x4*)(g + c), bv = *(const f32x4*)(bb + c);
            st_bf16x4(XN + (size_t)m * DM + c, (v[j] - mean) * rstd * gg + bv); }
      } }
    { float* COS = wsp<float>(F, WS_COS); float* SIN = wsp<float>(F, WS_SIN); const int* pos = (const int*)F.in[I_POS];
      for (int i = F.bid * NTHREADS + F.tid; i < M * 32; i += F.G * NTHREADS) { const int m = i >> 5, k = i & 31;
        const float invf = 1.0f / powf(10000.0f, (float)k * (1.0f / 32.0f));
        const float ang = (float)pos[m] * invf;
        const double rev = (double)ang * 0.15915494309189535; const float fr = (float)(rev - floor(rev));
        COS[i] = __builtin_amdgcn_cosf(fr); SIN[i] = __builtin_amdgcn_sinf(fr); }
      float* LBF = wsp<float>(F, WS_LBF); float* LBB = wsp<float>(F, WS_LBB);
      for (int i = F.bid * NTHREADS + F.tid; i < 2 * HGW; i += F.G * NTHREADS) { const bool fw = i < HGW; const int c = fw ? i : i - HGW; const float* lb = fw ? F.in[I_LBF] : F.in[I_LBB];
        const float v = 1.0f / (1.0f + __expf(lb[HGW + c] - lb[c])); (fw ? LBF : LBB)[c] = v; } }
}

__device__ __forceinline__ void p_ssq_naive(Frame& F) {
    const bf16_t* QA = wsp<bf16_t>(F, WS_QA); const bf16_t* KVA = wsp<bf16_t>(F, WS_KVA); float* SSQQ = wsp<float>(F, WS_SSQQ); float* SSQKV = wsp<float>(F, WS_SSQKV);
    const int gw = F.bid * 8 + F.wave, NGW = F.G * 8;
    for (int m = gw; m < M; m += NGW) {
        float s = 0.f;
        for (int c = F.lane; c < QRANK; c += 64) { const float v = bf2f(QA[(size_t)m * QRANK + c]); s += v * v; }
        s = wave_sum(s);
        float t = 0.f;
        for (int c = F.lane; c < KVRANK; c += 64) { const float v = bf2f(KVA[(size_t)m * KVRANK + c]); t += v * v; }
        t = wave_sum(t);
        if (F.lane < 8) SSQQ[(size_t)m * 8 + F.lane] = F.lane == 0 ? s : 0.f;
        if (F.lane < 4) SSQKV[(size_t)m * 4 + F.lane] = F.lane == 0 ? t : 0.f;
    }
}

__device__ __forceinline__ void p_attn_naive(Frame& F) {
    const bf16_t* QAT = wsp<bf16_t>(F, WS_QAT); const bf16_t* KV = wsp<bf16_t>(F, WS_KV); const bf16_t* KPE = wsp<bf16_t>(F, WS_KPE); bf16_t* MIXA = wsp<bf16_t>(F, WS_MIXA);
    const float* g = F.in[I_ATG];
    LAS float* qs = (LAS float*)F.lds + F.wave * 192;
    LAS float* ps = (LAS float*)(F.lds + 8192) + F.wave * 2048;
    const int gw = F.bid * 8 + F.wave, NGW = F.G * 8;
    for (int item = gw; item < M * 4; item += NGW) {
        const int b = item / (4 * SEQ), h = (item / SEQ) % 4, t = item % SEQ; const size_t m = (size_t)b * SEQ + t;
        for (int d = F.lane; d < 192; d += 64) qs[d] = bf2f(QAT[m * NQ + h * 192 + d]);
        asm volatile("s_waitcnt lgkmcnt(0)" ::: "memory");
        float mx = -1e30f;
#pragma unroll 1
        for (int i = 0; i < 32; ++i) { const size_t kr = (size_t)b * SEQ + F.lane + 64 * i; float s = 0.f;
            const bf16_t* kn = KV + kr * NKV + h * 256;
#pragma unroll 4
            for (int d = 0; d < 128; d += 8) { const bf16x8 kv = *(const bf16x8*)(kn + d);
#pragma unroll
                for (int j = 0; j < 8; ++j) s = fmaf(qs[d + j], bf2f((bf16_t)kv[j]), s); }
            const bf16_t* kp = KPE + kr * ROPE;
#pragma unroll 4
            for (int d = 0; d < 64; d += 8) { const bf16x8 kv = *(const bf16x8*)(kp + d);
#pragma unroll
                for (int j = 0; j < 8; ++j) s = fmaf(qs[128 + d + j], bf2f((bf16_t)kv[j]), s); }
            s *= ATT_SCALE; ps[F.lane + 64 * i] = s; mx = fmaxf(mx, s); }
        mx = wave_max(mx); float sum = 0.f;
#pragma unroll 1
        for (int i = 0; i < 32; ++i) { const float pv = __expf(ps[F.lane + 64 * i] - mx); sum += pv; ps[F.lane + 64 * i] = pv; }
        sum = wave_sum(sum);
        asm volatile("s_waitcnt lgkmcnt(0)" ::: "memory");
        float o0 = 0.f, o1 = 0.f; const bf16_t* vb = KV + (size_t)b * SEQ * NKV + h * 256 + 128 + 2 * F.lane;
        for (int j = 0; j < SEQ; ++j) { const unsigned w = *(const unsigned*)(vb + (size_t)j * NKV); const float pj = ps[j];
            o0 = fmaf(pj, __uint_as_float(w << 16), o0); o1 = fmaf(pj, __uint_as_float(w & 0xffff0000u), o1); }
        const float inv = 1.0f / sum; o0 *= inv; o1 *= inv;
        const float ss = wave_sum(o0 * o0 + o1 * o1); const float rs = 1.0f / sqrtf(ss * (1.0f / 128.0f) + EPS);
        *(unsigned*)(MIXA + m * DM + 512 + h * 128 + 2 * F.lane) = cvt_pk_bf16(o0 * rs * g[2 * F.lane], o1 * rs * g[2 * F.lane + 1]);
        asm volatile("s_waitcnt lgkmcnt(0)" ::: "memory");
    }
}

__device__ __forceinline__ void p_hgrn_scan(Frame& F) {
    const bf16_t* QHG = wsp<bf16_t>(F, WS_QHG); const bf16_t* VHG = wsp<bf16_t>(F, WS_VHG); const float* FFp = wsp<float>(F, WS_FF); const float* FBp = wsp<float>(F, WS_FB);
    float* OF = F.out; float* OB = F.out + (size_t)M * HGW;
    LAS float* qs = (LAS float*)F.lds;
    LAS float* fs = qs + 32 * 128;
    LAS float* vs_ = fs + 32 * 128;
    LAS float* op = vs_ + 32 * 32;
    const int tid = F.tid, vv = tid & 31, ks = tid >> 5;
    for (int item = F.bid; item < 256; item += F.G) {
        const int vsl = item & 3, dir = (item >> 2) & 1, h = (item >> 3) & 3, b = item >> 5;
        const float* Fp = dir ? FBp : FFp; float* O = dir ? OB : OF;
        float S[8];
#pragma unroll
        for (int j = 0; j < 8; ++j) S[j] = 0.f;
        for (int c = 0; c < SEQ / 32; ++c) {
            { const int i = tid >> 4, k0 = (tid & 15) * 8; const int s = c * 32 + i, t = dir ? SEQ - 1 - s : s; const size_t row = (size_t)b * SEQ + t;
              const bf16x8 qv = *(const bf16x8*)(QHG + row * HGW + h * 128 + k0);
              const f32x4 f0 = *(const f32x4*)(Fp + row * HGW + h * 128 + k0), f1 = *(const f32x4*)(Fp + row * HGW + h * 128 + k0 + 4);
#pragma unroll
              for (int j = 0; j < 8; ++j) qs[i * 128 + k0 + j] = bf2f((bf16_t)qv[j]);
              *(LAS f32x4*)(fs + i * 128 + k0) = f0; *(LAS f32x4*)(fs + i * 128 + k0 + 4) = f1;
              if (tid < 128) { const int i2 = tid >> 2, v0 = (tid & 3) * 8; const int s2 = c * 32 + i2, t2 = dir ? SEQ - 1 - s2 : s2; const size_t row2 = (size_t)b * SEQ + t2;
                const bf16x8 vvv = *(const bf16x8*)(VHG + row2 * HGW + h * 128 + vsl * 32 + v0);
#pragma unroll
                for (int j = 0; j < 8; ++j) vs_[i2 * 32 + v0 + j] = bf2f((bf16_t)vvv[j]); } }
            __syncthreads();
            for (int i = 0; i < 32; ++i) {
                const f32x4 q0 = *(const LAS f32x4*)(qs + i * 128 + ks * 8), q1 = *(const LAS f32x4*)(qs + i * 128 + ks * 8 + 4);
                const f32x4 f0 = *(const LAS f32x4*)(fs + i * 128 + ks * 8), f1 = *(const LAS f32x4*)(fs + i * 128 + ks * 8 + 4);
                const float v = vs_[i * 32 + vv]; float o = 0.f;
#pragma unroll
                for (int j = 0; j < 4; ++j) { S[j] = fmaf(f0[j], S[j] - v, v); o = fmaf(S[j], q0[j], o); S[4 + j] = fmaf(f1[j], S[4 + j] - v, v); o = fmaf(S[4 + j], q1[j], o); }
                o += __shfl_xor(o, 32);
                if (F.lane < 32) op[(F.wave * 32 + i) * 32 + vv] = o;
            }
            __syncthreads();
#pragma unroll
            for (int rr = 0; rr < 2; ++rr) { const int i = (tid >> 5) + 16 * rr; float o = 0.f;
#pragma unroll
                for (int w = 0; w < 8; ++w) o += op[(w * 32 + i) * 32 + vv];
                const int s = c * 32 + i, t = dir ? SEQ - 1 - s : s;
                O[((size_t)b * SEQ + t) * HGW + h * 128 + vsl * 32 + vv] = o; }
            __syncthreads();
        }
    }
}

__device__ __forceinline__ void p_hgrn_combine(Frame& F) {
    const float* OF = F.out; const float* OB = F.out + (size_t)M * HGW; const bf16_t* GATE = wsp<bf16_t>(F, WS_GATE); bf16_t* MIXA = wsp<bf16_t>(F, WS_MIXA);
    const float* g = F.in[I_HGG];
    const int gw = F.bid * 8 + F.wave, NGW = F.G * 8;
    for (int m = gw; m < M; m += NGW) {
        const size_t base = (size_t)m * HGW + F.lane * 8;
        const f32x4 a0 = *(const f32x4*)(OF + base), a1 = *(const f32x4*)(OF + base + 4), b0 = *(const f32x4*)(OB + base), b1 = *(const f32x4*)(OB + base + 4);
        const f32x4 o0 = a0 + b0, o1 = a1 + b1;
        float ss = (o0[0] * o0[0] + o0[1] * o0[1]) + (o0[2] * o0[2] + o0[3] * o0[3]) + (o1[0] * o1[0] + o1[1] * o1[1]) + (o1[2] * o1[2] + o1[3] * o1[3]);
        ss += __shfl_xor(ss, 1); ss += __shfl_xor(ss, 2); ss += __shfl_xor(ss, 4); ss += __shfl_xor(ss, 8);
        const float rs = 1.0f / sqrtf(ss * (1.0f / 128.0f) + EPS);
        const int gc = (F.lane & 15) * 8; const f32x4 g0 = *(const f32x4*)(g + gc), g1 = *(const f32x4*)(g + gc + 4);
        const bf16x8 gt = *(const bf16x8*)(GATE + base);
        f32x4 y0, y1;
#pragma unroll
        for (int j = 0; j < 4; ++j) { y0[j] = o0[j] * rs * g0[j] * bf2f((bf16_t)gt[j]); y1[j] = o1[j] * rs * g1[j] * bf2f((bf16_t)gt[4 + j]); }
        u32x4 w; w.x = cvt_pk_bf16(y0[0], y0[1]); w.y = cvt_pk_bf16(y0[2], y0[3]); w.z = cvt_pk_bf16(y1[0], y1[1]); w.w = cvt_pk_bf16(y1[2], y1[3]);
        *(u32x4*)(MIXA + (size_t)m * DM + F.lane * 8) = w;
    }
}

__device__ __forceinline__ void p_ln_pass(Frame& F, const float* Y, const float* g, const float* bb, float* dst, bf16_t* dstb) {
    const int gw = F.bid * 8 + F.wave, NGW = F.G * 8;
    for (int m = gw; m < M; m += NGW) {
        const f32x4* xr = (const f32x4*)(Y + (size_t)m * DM) + F.lane;
        f32x4 v[4]; float s = 0.f;
#pragma unroll
        for (int j = 0; j < 4; ++j) { v[j] = xr[64 * j]; s += (v[j][0] + v[j][1]) + (v[j][2] + v[j][3]); }
        const float mean = wave_sum(s) * (1.f / DM); float s2 = 0.f;
#pragma unroll
        for (int j = 0; j < 4; ++j) { const f32x4 d = v[j] - mean; s2 += (d[0] * d[0] + d[1] * d[1]) + (d[2] * d[2] + d[3] * d[3]); }
        const float rstd = 1.f / sqrtf(wave_sum(s2) * (1.f / DM) + EPS);
#pragma unroll
        for (int j = 0; j < 4; ++j) { const int c = 4 * F.lane + 256 * j; const f32x4 gg = *(const f32x4*)(g + c), bv = *(const f32x4*)(bb + c);
            const f32x4 o = (v[j] - mean) * rstd * gg + bv; *(f32x4*)(dst + (size_t)m * DM + c) = o; if (dstb) st_bf16x4(dstb + (size_t)m * DM + c, o); }
    }
}

__device__ __forceinline__ void p_glu_naive(Frame& F, int hh) {
    const bf16_t* UH = wsp<bf16_t>(F, WS_UH); bf16_t* ACT = wsp<bf16_t>(F, WS_ACT); const float* CW = F.in[I_CW]; const float* CBv = F.in[I_CB];
    const int total = 8192 * (DFF / 8);
    for (int idx = F.bid * NTHREADS + F.tid; idx < total; idx += F.G * NTHREADS) {
        const int tl = idx / (DFF / 8), ch = (idx % (DFF / 8)) * 8; const int t = hh * 8192 + tl, pos = t % SEQ;
        const int pa = (ch >> 7) * 256 + (ch & 127), pb = pa + 128;
        const bool hp = pos > 0, hn = pos < SEQ - 1;
        bf16x8 z = {0, 0, 0, 0, 0, 0, 0, 0};
        const bf16x8 a0 = hp ? *(const bf16x8*)(UH + (size_t)(tl - 1) * NUP + pa) : z, a1 = *(const bf16x8*)(UH + (size_t)tl * NUP + pa), a2 = hn ? *(const bf16x8*)(UH + (size_t)(tl + 1) * NUP + pa) : z;
        const bf16x8 b0 = hp ? *(const bf16x8*)(UH + (size_t)(tl - 1) * NUP + pb) : z, b1 = *(const bf16x8*)(UH + (size_t)tl * NUP + pb), b2 = hn ? *(const bf16x8*)(UH + (size_t)(tl + 1) * NUP + pb) : z;
        float y[8];
#pragma unroll
        for (int j = 0; j < 8; ++j) { const int c = ch + j;
            const float ca = CW[c] * bf2f((bf16_t)a0[j]) + CW[NUP + c] * bf2f((bf16_t)a1[j]) + CW[2 * NUP + c] * bf2f((bf16_t)a2[j]) + CBv[c];
            const float cb = CW[DFF + c] * bf2f((bf16_t)b0[j]) + CW[NUP + DFF + c] * bf2f((bf16_t)b1[j]) + CW[2 * NUP + DFF + c] * bf2f((bf16_t)b2[j]) + CBv[DFF + c];
            y[j] = gelu_tanh(ca) * cb; }
        u32x4 w; w.x = cvt_pk_bf16(y[0], y[1]); w.y = cvt_pk_bf16(y[2], y[3]); w.z = cvt_pk_bf16(y[4], y[5]); w.w = cvt_pk_bf16(y[6], y[7]);
        *(u32x4*)(ACT + (size_t)t * DFF + ch) = w;
    }
}

__device__ __forceinline__ void down_fixup(Frame& F, int pm) {
    const float* HALO = wsp<float>(F, WS_HALO); bf16_t* ACT = wsp<bf16_t>(F, WS_ACT); const float* CW = F.in[I_CW]; const float* CBv = F.in[I_CB];
    for (int idx = F.tid; idx < 2 * DFF; idx += NTHREADS) {
        const int which = idx / DFF, ch = idx % DFF;
        const float* P; const float* C; const float* N;
        if (which == 0) { P = (pm % 8 == 0) ? nullptr : HALO + ((size_t)(pm - 1) * 4 + 3) * NUP; C = HALO + ((size_t)pm * 4 + 0) * NUP; N = HALO + ((size_t)pm * 4 + 1) * NUP; }
        else { P = HALO + ((size_t)pm * 4 + 2) * NUP; C = HALO + ((size_t)pm * 4 + 3) * NUP; N = (pm % 8 == 7) ? nullptr : HALO + ((size_t)(pm + 1) * 4 + 0) * NUP; }
        const float pa = P ? P[ch] : 0.f, pb = P ? P[DFF + ch] : 0.f, na = N ? N[ch] : 0.f, nb = N ? N[DFF + ch] : 0.f;
        const float ca = CW[ch] * pa + CW[NUP + ch] * C[ch] + CW[2 * NUP + ch] * na + CBv[ch];
        const float cb = CW[DFF + ch] * pb + CW[NUP + DFF + ch] * C[DFF + ch] + CW[2 * NUP + DFF + ch] * nb + CBv[DFF + ch];
        const float y = gelu_tanh(ca) * cb;
        ACT[(size_t)(pm * 256 + (which ? 255 : 0)) * DFF + ch] = (bf16_t)(cvt_pk_bf16(y, 0.f) & 0xffffu);
    }
    asm volatile("s_waitcnt vmcnt(0)" ::: "memory");
    __syncthreads();
}


namespace att {
constexpr int NW = 8, QBLK = 32, KVBLK = 64;
constexpr int SHM_V = KVBLK * 128 * 2, SHM_KN = KVBLK * 128 * 2, SHM_KR = KVBLK * 64 * 2;
constexpr int OFF_V = 0, OFF_KN = 2 * SHM_V, OFF_KR = OFF_KN + 2 * SHM_KN, OFF_WS = OFF_KR + 2 * SHM_KR, OFF_QR = OFF_WS + NW * 64 * 4, SHM_ATTN = OFF_QR + NW * 4096;
static_assert(SHM_ATTN <= RING_BYTES, "attention LDS");
#ifndef ATT_SDEPTH
#define ATT_SDEPTH 1
#endif
constexpr int SDEPTH = ATT_SDEPTH;
constexpr float THR = 8.f;
#define KSWZ(row, colB) ((row) * 256 + ((colB) ^ (((row) & 7) << 4)))
#define KRSWZ(row, colB) ((row) * 128 + ((colB) ^ (((row) & 7) << 4)))
#define SBAR() __builtin_amdgcn_sched_barrier(0)
__device__ __forceinline__ int crow(int r, int hi) { return (r & 3) + 8 * (r >> 2) + 4 * hi; }
__device__ __forceinline__ unsigned cvtpk(float lo, float hi) { unsigned r; asm volatile("v_cvt_pk_bf16_f32 %0, %1, %2" : "=v"(r) : "v"(lo), "v"(hi)); return r; }

__device__ __forceinline__ void partialSM(f32x16& p0, f32x16& p1, float& m_reg, float& mn, float& alpha) {
  constexpr float C = ATT_SCALE * 1.4426950408889634f;
  float pmax = p0[0];
#pragma unroll
  for (int r = 1; r < 16; ++r) pmax = fmaxf(pmax, p0[r]);
#pragma unroll
  for (int r = 0; r < 16; ++r) pmax = fmaxf(pmax, p1[r]);
  { auto rr = __builtin_amdgcn_permlane32_swap(__float_as_uint(pmax), __float_as_uint(pmax), false, false);
    pmax = fmaxf(__uint_as_float(rr[0]), __uint_as_float(rr[1])); }
  if (__builtin_expect(__all(pmax - m_reg <= THR / ATT_SCALE), 1)) { mn = m_reg; alpha = 1.f; }
  else { mn = fmaxf(m_reg, pmax); alpha = __builtin_amdgcn_exp2f((m_reg - mn) * C); m_reg = mn; }
  float mnC = -mn * C;
#pragma unroll
  for (int r = 0; r < 16; ++r) p0[r] = fmaf(p0[r], C, mnC);
#pragma unroll
  for (int r = 0; r < 16; ++r) p1[r] = fmaf(p1[r], C, mnC);
#pragma unroll
  for (int r = 0; r < 16; ++r) p0[r] = __builtin_amdgcn_exp2f(p0[r]);
}
__device__ __forceinline__ void finishSM(f32x16& p0, f32x16& p1, float alpha, float& l_reg, bf16x8& pa0, bf16x8& pa1, bf16x8& pa2, bf16x8& pa3) {
#pragma unroll
  for (int r = 0; r < 16; ++r) p1[r] = __builtin_amdgcn_exp2f(p1[r]);
  float ps = 0;
#pragma unroll
  for (int r = 0; r < 16; ++r) ps += p0[r];
#pragma unroll
  for (int r = 0; r < 16; ++r) ps += p1[r];
  { auto rr = __builtin_amdgcn_permlane32_swap(__float_as_uint(ps), __float_as_uint(ps), false, false);
    ps = __uint_as_float(rr[0]) + __uint_as_float(rr[1]); }
  l_reg = l_reg * alpha + ps;
#define PK4(P, BASE, OUT) do { unsigned a0 = cvtpk(P[BASE + 0], P[BASE + 1]), a1 = cvtpk(P[BASE + 2], P[BASE + 3]);   \
    unsigned b0 = cvtpk(P[BASE + 4], P[BASE + 5]), b1 = cvtpk(P[BASE + 6], P[BASE + 7]);                              \
    auto r0 = __builtin_amdgcn_permlane32_swap(a0, b0, false, false); auto r1 = __builtin_amdgcn_permlane32_swap(a1, b1, false, false); \
    u32x4 w = {r0[0], r1[0], r0[1], r1[1]}; OUT = *reinterpret_cast<bf16x8*>(&w); } while (0)
  PK4(p0, 0, pa0); PK4(p0, 8, pa1); PK4(p1, 0, pa2); PK4(p1, 8, pa3);
#undef PK4
}
__device__ __forceinline__ void qkt(f32x16& p0, f32x16& p1, const char* Kn, const char* Kr, const bf16x8* qr, const char* qpark, int r32, int hi) {
  p0 = f32x16{}; p1 = f32x16{};
#pragma unroll
  for (int d0 = 0; d0 < 8; ++d0) { int cb = (d0 * 16 + hi * 8) * 2;
    bf16x8 b0 = *reinterpret_cast<const bf16x8*>(Kn + KSWZ(r32, cb));
    bf16x8 b1 = *reinterpret_cast<const bf16x8*>(Kn + KSWZ(32 + r32, cb));
    p0 = __builtin_amdgcn_mfma_f32_32x32x16_bf16(b0, qr[d0], p0, 0, 0, 0);
    p1 = __builtin_amdgcn_mfma_f32_32x32x16_bf16(b1, qr[d0], p1, 0, 0, 0); }
#pragma unroll
  for (int d0 = 0; d0 < 4; ++d0) { int cb = (d0 * 16 + hi * 8) * 2;
    bf16x8 b0 = *reinterpret_cast<const bf16x8*>(Kr + KRSWZ(r32, cb));
    bf16x8 b1 = *reinterpret_cast<const bf16x8*>(Kr + KRSWZ(32 + r32, cb));
    const bf16x8 qv = *reinterpret_cast<const bf16x8*>(qpark + d0 * 1024);
    p0 = __builtin_amdgcn_mfma_f32_32x32x16_bf16(b0, qv, p0, 0, 0, 0);
    p1 = __builtin_amdgcn_mfma_f32_32x32x16_bf16(b1, qv, p1, 0, 0, 0); }
}
__device__ __forceinline__ int v_st(int k, int c) { const int kk = (k & ~0xC) | ((k & 4) << 1) | ((k & 8) >> 1); return ((kk >> 3) * 4 + (c >> 5)) * 512 + ((kk & 7) * 32 + (c & 31)) * 2; }
__device__ __forceinline__ int v_rd_base(int lane) { return ((lane & 3) << 3) | (((lane >> 2) & 3) << 6) | (((lane >> 4) & 1) << 5) | (((lane >> 5) & 1) << 8); }
constexpr int v_rd_off(int d0, int ks, int half) { return d0 * 512 + ks * 4096 + half * 2048; }
template <int OFF> __device__ __forceinline__ s16x4 tr_read(int vb) {
  s16x4 r; asm volatile("ds_read_b64_tr_b16 %0, %1 offset:%2" : "=&v"(r) : "v"(vb), "i"(OFF) : "memory"); return r;
}
template <int D0> __device__ __forceinline__ void pv_one(f32x16& od, int vb, bf16x8 pa0, bf16x8 pa1, bf16x8 pa2, bf16x8 pa3) {
  const s16x4 l0 = tr_read<v_rd_off(D0, 0, 0)>(vb), h0 = tr_read<v_rd_off(D0, 0, 1)>(vb), l1 = tr_read<v_rd_off(D0, 1, 0)>(vb), h1 = tr_read<v_rd_off(D0, 1, 1)>(vb);
  const s16x4 l2 = tr_read<v_rd_off(D0, 2, 0)>(vb), h2 = tr_read<v_rd_off(D0, 2, 1)>(vb), l3 = tr_read<v_rd_off(D0, 3, 0)>(vb), h3 = tr_read<v_rd_off(D0, 3, 1)>(vb);
  asm volatile("s_waitcnt lgkmcnt(0)" ::: "memory"); SBAR();
#define PK(L, H) (bf16x8){L[0], L[1], L[2], L[3], H[0], H[1], H[2], H[3]}
  od = __builtin_amdgcn_mfma_f32_32x32x16_bf16(pa0, PK(l0, h0), od, 0, 0, 0);
  od = __builtin_amdgcn_mfma_f32_32x32x16_bf16(pa1, PK(l1, h1), od, 0, 0, 0);
  od = __builtin_amdgcn_mfma_f32_32x32x16_bf16(pa2, PK(l2, h2), od, 0, 0, 0);
  od = __builtin_amdgcn_mfma_f32_32x32x16_bf16(pa3, PK(l3, h3), od, 0, 0, 0);
#undef PK
}
__device__ __forceinline__ void pv_d0(f32x16* o, int vb, bf16x8 pa0, bf16x8 pa1, bf16x8 pa2, bf16x8 pa3) {
  pv_one<0>(o[0], vb, pa0, pa1, pa2, pa3); pv_one<1>(o[1], vb, pa0, pa1, pa2, pa3); pv_one<2>(o[2], vb, pa0, pa1, pa2, pa3); pv_one<3>(o[3], vb, pa0, pa1, pa2, pa3);
}
constexpr int LDQ = NQ, LDK = NKV, LDKR = ROPE, LDO = DM;
__device__ __forceinline__ void attn_unit(const bf16_t* Qb, const bf16_t* Kn, const bf16_t* Vh, const bf16_t* Kr, bf16_t* Ob, const float* gn, int seq, char* lds, int tid) {
  const int wid = tid >> 6, lane = tid & 63, r32 = lane & 31, hi = lane >> 5;
  char* V_lds = lds + OFF_V; char* KN_lds = lds + OFF_KN; char* KR_lds = lds + OFF_KR;
  float* ws = (float*)(lds + OFF_WS) + wid * 64; float* li_l = ws; float* al_l = ws + 32;
  float m_reg = -1e30f, l_reg = 0; f32x16 o[4] = {}; bf16x8 qr[8];
  char* qpark = lds + OFF_QR + wid * 4096 + lane * 16;
  const bf16_t* Qw = Qb + (long)(wid * QBLK + r32) * LDQ + hi * 8;
#pragma unroll
  for (int d0 = 0; d0 < 8; ++d0) qr[d0] = *reinterpret_cast<const bf16x8*>(Qw + d0 * 16);
#pragma unroll
  for (int d0 = 0; d0 < 4; ++d0) *reinterpret_cast<bf16x8*>(qpark + d0 * 1024) = *reinterpret_cast<const bf16x8*>(Qw + 128 + d0 * 16);
  const int sr = tid >> 4, sc = (tid & 15) * 8, vst0 = v_st(sr, sc), vst1 = v_st(32 + sr, sc);
  const int krr = tid >> 3, krc = (tid & 7) * 8;
  const int vb0 = (int)(uintptr_t)V_lds + v_rd_base(lane);
  struct { bf16x8 vs0, vs1, ks0, ks1, kr; } sr_[SDEPTH];
#define SLOAD(i, k0) do { sr_[i].vs0 = *(const bf16x8*)(&Vh[(long)((k0) + sr) * LDK + sc]); sr_[i].vs1 = *(const bf16x8*)(&Vh[(long)((k0) + 32 + sr) * LDK + sc]); \
    sr_[i].ks0 = *(const bf16x8*)(&Kn[(long)((k0) + sr) * LDK + sc]); sr_[i].ks1 = *(const bf16x8*)(&Kn[(long)((k0) + 32 + sr) * LDK + sc]); \
    sr_[i].kr = *(const bf16x8*)(&Kr[(long)((k0) + krr) * LDKR + krc]); } while (0)
#define SWRITE(b, i) do { *(bf16x8*)(V_lds + (b) * SHM_V + vst0) = sr_[i].vs0; *(bf16x8*)(V_lds + (b) * SHM_V + vst1) = sr_[i].vs1; int kc = sc * 2;               \
    *(bf16x8*)(KN_lds + (b) * SHM_KN + KSWZ(sr, kc)) = sr_[i].ks0; *(bf16x8*)(KN_lds + (b) * SHM_KN + KSWZ(32 + sr, kc)) = sr_[i].ks1; \
    *(bf16x8*)(KR_lds + (b) * SHM_KR + KRSWZ(krr, krc * 2)) = sr_[i].kr; } while (0)
#define SWAIT() do { if constexpr (SDEPTH == 2) asm volatile("s_waitcnt vmcnt(5)" ::: "memory"); else asm volatile("s_waitcnt vmcnt(0)" ::: "memory"); } while (0)
#define RESC(a) do { if (__any((a) < 1.f)) { if (hi == 0) al_l[r32] = (a); asm volatile("s_waitcnt lgkmcnt(0)" ::: "memory"); \
    _Pragma("unroll") for (int d = 0; d < 4; ++d) _Pragma("unroll") for (int r = 0; r < 16; ++r) o[d][r] *= al_l[crow(r, hi)]; } } while (0)
  f32x16 p0, p1; float mn, al; bf16x8 pa0, pa1, pa2, pa3; const int NT = seq / KVBLK;
  SLOAD(0, 0); asm volatile("s_waitcnt vmcnt(0)" ::: "memory"); SWRITE(0, 0); __syncthreads();
  for (int j = 0; j < NT; ++j) {
    const int b = j & 1;
    SBAR(); qkt(p0, p1, KN_lds + b * SHM_KN, KR_lds + b * SHM_KR, qr, qpark, r32, hi);
    partialSM(p0, p1, m_reg, mn, al);
    RESC(al);
    finishSM(p0, p1, al, l_reg, pa0, pa1, pa2, pa3); SBAR();
    if (j + 1 < NT) SLOAD(0, (j + 1) * KVBLK);
    SBAR();
    pv_d0(o, vb0 + b * (int)SHM_V, pa0, pa1, pa2, pa3);
    if (j + 1 < NT) { asm volatile("s_waitcnt vmcnt(0)" ::: "memory"); SWRITE(b ^ 1, 0); }
    __syncthreads();
  }
  if (hi == 0) li_l[r32] = l_reg; asm volatile("s_waitcnt lgkmcnt(0)" ::: "memory");
  bf16_t* Ow = Ob + (long)(wid * QBLK) * LDO;
  float g4[4];
#pragma unroll
  for (int d0 = 0; d0 < 4; ++d0) g4[d0] = gn[d0 * 32 + r32];
#pragma unroll
  for (int r = 0; r < 16; ++r) { const int orow = crow(r, hi); const float rl = __builtin_amdgcn_rcpf(li_l[orow]);
    float v[4], ss = 0.f;
#pragma unroll
    for (int d0 = 0; d0 < 4; ++d0) { v[d0] = o[d0][r] * rl; ss += v[d0] * v[d0]; }
    ss += __shfl_xor(ss, 1); ss += __shfl_xor(ss, 2); ss += __shfl_xor(ss, 4); ss += __shfl_xor(ss, 8); ss += __shfl_xor(ss, 16);
    const float rs = 1.0f / sqrtf(ss * (1.0f / 128.0f) + EPS);
#pragma unroll
    for (int d0 = 0; d0 < 4; ++d0) Ow[(long)orow * LDO + d0 * 32 + r32] = (bf16_t)(cvtpk(v[d0] * rs * g4[d0], 0.f) & 0xffffu); }
  __syncthreads();
#undef SLOAD
#undef SWRITE
#undef SWAIT
#undef RESC
}
#undef KSWZ
#undef KRSWZ
#undef SBAR
}

#define XB_TMO      128
#define XB_XCNT(j)  (256  + 64 * (j))
#define XB_XSUB(j)  (1280 + 64 * (j))
#define XB_XGEN(j)  (2304 + 64 * (j))
#define XB_TOP      3328
#define XB_TOPGEN   3392
#define XCD_BAR_WORDS 3456
#define XB_SPIN_CAP (1u << 18)
__device__ __forceinline__ unsigned xb_ld(unsigned* p)              { return __hip_atomic_load(p, __ATOMIC_RELAXED, __HIP_MEMORY_SCOPE_AGENT); }
__device__ __forceinline__ unsigned xb_add(unsigned* p, unsigned v) { return __hip_atomic_fetch_add(p, v, __ATOMIC_RELAXED, __HIP_MEMORY_SCOPE_AGENT); }
__device__ __forceinline__ unsigned xb_xcc_id() { return (unsigned)__builtin_amdgcn_s_getreg((3 << 11) | 20) & 0xFu; }
#define XB_SPIN(cond, bar) do { unsigned _sp = 0; while (cond) { __builtin_amdgcn_s_sleep(1); \
    if ((++_sp & 255u) == 0u) { if (xb_ld(&(bar)[XB_TMO])) break; if (_sp > XB_SPIN_CAP) { atomicAdd(&(bar)[XB_TMO], 1u); break; } } } } while (0)
struct XcdBarrier { unsigned* bar; unsigned x; volatile LAS unsigned* st; };
__device__ __forceinline__ XcdBarrier xcd_barrier_post(unsigned* bar, volatile LAS unsigned* st, int tid) {
    XcdBarrier b; b.bar = bar; b.x = xb_xcc_id(); b.st = st;
    if (tid == 0) (void)xb_add(&bar[XB_XCNT(b.x)], 1u);
    return b;
}
__device__ __forceinline__ void xcd_barrier_complete(unsigned* bar, unsigned x, unsigned G, unsigned& nloc, unsigned& nx) {
    unsigned sum, cnt, mine, sp = 0u;
    for (;;) {
        sum = 0u; cnt = 0u; mine = 0u;
#pragma unroll
        for (unsigned j = 0; j < 16; ++j) { const unsigned c = xb_ld(&bar[XB_XCNT(j)]); sum += c; cnt += (c > 0u) ? 1u : 0u; mine = (j == x) ? c : mine; }
        if (sum == G) break;
        __builtin_amdgcn_s_sleep(1);
        if ((++sp & 255u) == 0u) { if (xb_ld(&bar[XB_TMO])) break; if (sp > XB_SPIN_CAP) { atomicAdd(&bar[XB_TMO], 1u); break; } }
    }
    nloc = mine > 0u ? mine : 1u; nx = cnt > 0u ? cnt : 1u;
}
__device__ __forceinline__ void xcd_barrier(const XcdBarrier& b, int tid, unsigned G) {
    asm volatile("s_waitcnt vmcnt(0)" ::: "memory");
    __syncthreads();
    if (tid == 0) {
        unsigned* bar = b.bar;
        __builtin_amdgcn_s_waitcnt(0);
        unsigned nloc = b.st[0], nx = b.st[1];
        if (nloc == 0u) { xcd_barrier_complete(bar, b.x, G, nloc, nx); b.st[0] = nloc; b.st[1] = nx; }
        const unsigned old = xb_add(&bar[XB_XSUB(b.x)], 1u);
        const unsigned gen = old / nloc;
        if (old + 1u == (gen + 1u) * nloc) {
            __builtin_amdgcn_fence(__ATOMIC_RELEASE, "agent");
            asm volatile("s_waitcnt vmcnt(0)" ::: "memory");
            const unsigned og = xb_add(&bar[XB_TOP], 1u);
            const unsigned tg = og / nx;
            if (og + 1u == (tg + 1u) * nx) xb_add(&bar[XB_TOPGEN], 1u);
            else XB_SPIN(xb_ld(&bar[XB_TOPGEN]) == tg, bar);
            __builtin_amdgcn_fence(__ATOMIC_ACQUIRE, "agent");
            xb_add(&bar[XB_XGEN(b.x)], 1u);
            asm volatile("s_waitcnt vmcnt(0)" ::: "memory");
        } else {
            XB_SPIN(xb_ld(&bar[XB_XGEN(b.x)]) == gen, bar);
            __builtin_amdgcn_fence(__ATOMIC_ACQUIRE, "agent");
            asm volatile("s_waitcnt vmcnt(0)" ::: "memory");
        }
    }
    __syncthreads();
}

constexpr int PH_PRO = 0, PH_INPROJ = 1, PH_SSQ = 2, PH_QKV = 3, PH_ATT = 4, PH_SCAN = 5, PH_COMB = 6, PH_OUT = 7, PH_LN1 = 8, PH_UP = 9, PH_GLU0 = 10, PH_UP1 = 11, PH_GLU1 = 12, PH_FIX = 13, PH_DOWN = 14, PH_LN2 = 15, PH_N = 16;

#ifndef MK_PHMASK
#define MK_PHMASK 0xFFFFFFFFu
#endif
__host__ __device__ constexpr bool phase_on(int ph) {
    return !((ph == PH_SSQ && !(NAIVE & NV_IN)) || ((ph == PH_GLU0 || ph == PH_UP1 || ph == PH_GLU1) && !(NAIVE & NV_UP)) || (ph == PH_FIX && !(!(NAIVE & NV_UP) && (NAIVE & NV_DOWN))));
}
template <int ph> __device__ __forceinline__ void run_phase(const Frame& F0) {
    using namespace pg8;
    if (!((MK_PHMASK >> ph) & 1u)) return;
    Frame F = F0; { int l = (int)__builtin_amdgcn_mbcnt_hi(~0u, __builtin_amdgcn_mbcnt_lo(~0u, 0u)); asm volatile("" : "+v"(l)); F.lane = l; F.tid = F0.wave * 64 + l; }
    if constexpr (ph == PH_PRO) { p0_prologue(F); }
    else if constexpr (ph == PH_INPROJ) {
        QInProj q{wsp<bf16_t>(F, WS_QHG), wsp<bf16_t>(F, WS_VHG), wsp<bf16_t>(F, WS_GATE), wsp<bf16_t>(F, WS_QA), wsp<bf16_t>(F, WS_KVA), wsp<bf16_t>(F, WS_KPE),
                  wsp<float>(F, WS_FF), wsp<float>(F, WS_FB), wsp<float>(F, WS_LBF), wsp<float>(F, WS_LBB), wsp<float>(F, WS_COS), wsp<float>(F, WS_SIN)};
        if (NAIVE & NV_IN) naive_gemm(F.lds, F.tid, wsp<bf16_t>(F, WS_XN), DM, wsp<bf16_t>(F, WS_WIN), DM, 0, M, INCP, DM, q);
        else { Gemm g{wsp<bf16_t>(F, WS_XN), wsp<bf16_t>(F, WS_WIN), M, INCP, DM}; StaticOrder<M, INCP> S; S.init(F.G, F.bid);
               EpiInProj E{q, wsp<float>(F, WS_SSQQ), wsp<float>(F, WS_SSQKV)}; gemm_phase<DM, EpiInProj, StaticOrder<M, INCP>, true, true>(F.lds, F.tid, g, S, E); }
    }
    else if constexpr (ph == PH_SSQ) { if (NAIVE & NV_IN) p_ssq_naive(F); }
    else if constexpr (ph == PH_QKV) {
        QQb qq{wsp<bf16_t>(F, WS_QAT), wsp<float>(F, WS_SSQQ), wsp<float>(F, WS_COS), wsp<float>(F, WS_SIN)};
        QKvb qk{wsp<bf16_t>(F, WS_KV), wsp<float>(F, WS_SSQKV)};
        if (NAIVE & NV_QKV) { naive_gemm(F.lds, F.tid, wsp<bf16_t>(F, WS_QA), QRANK, wsp<bf16_t>(F, WS_WQB), QRANK, 0, M, NQ, QRANK, qq);
                              naive_gemm(F.lds, F.tid, wsp<bf16_t>(F, WS_KVA), KVRANK, wsp<bf16_t>(F, WS_WKVB), KVRANK, 0, M, NKV, KVRANK, qk); }
        else {
#ifndef SKIP_QB
 { Gemm g{wsp<bf16_t>(F, WS_QA), wsp<bf16_t>(F, WS_WQB), M, NQ, QRANK}; StaticOrder<M, NQ> S; S.init(F.G, F.bid); EpiQuad<QQb> E{qq}; gemm_phase<QRANK, EpiQuad<QQb>, StaticOrder<M, NQ>, true, true>(F.lds, F.tid, g, S, E); }
#endif
#ifndef SKIP_KVB
               { Gemm g{wsp<bf16_t>(F, WS_KVA), wsp<bf16_t>(F, WS_WKVB), M, NKV, KVRANK}; StaticOrder<M, NKV> S; S.init(F.G, F.bid); EpiQuad<QKvb> E{qk}; gemm_phase<KVRANK, EpiQuad<QKvb>, StaticOrder<M, NKV>, true, true>(F.lds, F.tid, g, S, E); }
#endif
 }
    }
    else if constexpr (ph == PH_ATT) {
        if (NAIVE & NV_ATT) p_attn_naive(F);
        else { const bf16_t* QAT = wsp<bf16_t>(F, WS_QAT); const bf16_t* KV = wsp<bf16_t>(F, WS_KV); const bf16_t* KPE = wsp<bf16_t>(F, WS_KPE); bf16_t* MIXA = wsp<bf16_t>(F, WS_MIXA);
            for (int u = F.vcu; u < 256; u += F.G) { const int bh = u >> 3, qb = u & 7, b = bh >> 2, h = bh & 3; const size_t row0 = (size_t)b * SEQ + qb * 256, k0 = (size_t)b * SEQ;
                att::attn_unit(QAT + row0 * NQ + h * 192, KV + k0 * NKV + h * 256, KV + k0 * NKV + h * 256 + 128, KPE + k0 * ROPE, MIXA + row0 * DM + 512 + h * 128, F.in[I_ATG], SEQ, (char*)F.lds, F.tid); } }
    }
    else if constexpr (ph == PH_SCAN) { p_hgrn_scan(F); }
    else if constexpr (ph == PH_COMB) { p_hgrn_combine(F); }
    else if constexpr (ph == PH_OUT) {
        QOut q{wsp<float>(F, WS_Y), F.in[I_X], wsp<float>(F, WS_MU0), wsp<float>(F, WS_RS0), F.in[I_LNG], F.in[I_LNB]};
        if (NAIVE & NV_OUT) naive_gemm(F.lds, F.tid, wsp<bf16_t>(F, WS_MIXA), DM, wsp<bf16_t>(F, WS_WOUT), DM, 0, M, DM, DM, q);
        else { Gemm g{wsp<bf16_t>(F, WS_MIXA), wsp<bf16_t>(F, WS_WOUT), M, DM, DM}; StaticOrder<M, DM> S; S.init(F.G, F.bid); EpiQuad<QOut> E{q}; gemm_phase<DM, EpiQuad<QOut>, StaticOrder<M, DM>, true, true>(F.lds, F.tid, g, S, E); }
    }
    else if constexpr (ph == PH_LN1) { p_ln_pass(F, wsp<float>(F, WS_Y), F.in[I_L1G], F.in[I_L1B], F.out, wsp<bf16_t>(F, WS_H1B)); }
    else if constexpr (ph == PH_UP) {
        if (NAIVE & NV_UP) { QUpNaive q{wsp<bf16_t>(F, WS_UH), 0}; naive_gemm(F.lds, F.tid, wsp<bf16_t>(F, WS_H1B), DM, wsp<bf16_t>(F, WS_WUP), DM, 0, 8192, NUP, DM, q); }
        else { Gemm g{wsp<bf16_t>(F, WS_H1B), wsp<bf16_t>(F, WS_WUP), M, NUP, DM}; StaticOrder<M, NUP> S; S.init(F.G, F.bid);
               EpiConvGlu E{wsp<bf16_t>(F, WS_ACT), wsp<float>(F, WS_HALO), F.in[I_CW], F.in[I_CB], (LAS float*)(F.lds + LDS_BND)}; gemm_phase<DM, EpiConvGlu, StaticOrder<M, NUP>, true, true>(F.lds, F.tid, g, S, E); }
    }
    else if constexpr (ph == PH_GLU0) { if (NAIVE & NV_UP) p_glu_naive(F, 0); }
    else if constexpr (ph == PH_UP1) { if (NAIVE & NV_UP) { QUpNaive q{wsp<bf16_t>(F, WS_UH), 8192}; naive_gemm(F.lds, F.tid, wsp<bf16_t>(F, WS_H1B), DM, wsp<bf16_t>(F, WS_WUP), DM, 8192, 8192, NUP, DM, q); } }
    else if constexpr (ph == PH_GLU1) { if (NAIVE & NV_UP) p_glu_naive(F, 1); }
    else if constexpr (ph == PH_FIX) { if (!(NAIVE & NV_UP) && (NAIVE & NV_DOWN)) { for (int pm = F.bid; pm < 64; pm += F.G) down_fixup(F, pm); } }
    else if constexpr (ph == PH_DOWN) {
        QDown q{wsp<float>(F, WS_Y), F.out};
        if (NAIVE & NV_DOWN) {
            naive_gemm(F.lds, F.tid, wsp<bf16_t>(F, WS_ACT), DFF, wsp<bf16_t>(F, WS_WDN), DFF, 0, M, DM, DFF, q);
        } else { Gemm g{wsp<bf16_t>(F, WS_ACT), wsp<bf16_t>(F, WS_WDN), M, DM, DFF}; StaticOrder<M, DM> S; S.init(F.G, F.bid);
            if (!(NAIVE & NV_UP)) { Unit u; if (S.next(0, u)) down_fixup(F, u.pm); }
            EpiQuad<QDown> E{q}; gemm_phase<DFF, EpiQuad<QDown>, StaticOrder<M, DM>, true, true>(F.lds, F.tid, g, S, E); }
    }
    else if constexpr (ph == PH_LN2) { p_ln_pass(F, wsp<float>(F, WS_Y), F.in[I_L2G], F.in[I_L2B], F.out, nullptr); }
}

__global__ void __launch_bounds__(NTHREADS, 2) mk_fwd(Params p) {
    extern __shared__ __attribute__((aligned(16))) unsigned char lds_raw[];
    Frame F;
    F.lds = (LAS unsigned char*)lds_raw;
    F.tid = threadIdx.x; F.lane = F.tid & 63; F.wave = __builtin_amdgcn_readfirstlane(F.tid >> 6);
    LAS unsigned* MISC = (LAS unsigned*)(F.lds + LDS_MISC);
    if (F.tid < 32) MISC[F.tid] = 0u;
    __syncthreads();
    F.G = gridDim.x; F.bid = blockIdx.x; F.vcu = (F.G % 8 == 0) ? (F.bid % 8) * (F.G / 8) + F.bid / 8 : F.bid;
    F.in = p.in; F.out = p.out; F.ws = p.ws;
#if MK_ONE_LAUNCH
    XcdBarrier xbar = xcd_barrier_post((unsigned*)(p.ws + WS_CTL) + 1024, (volatile LAS unsigned*)(MISC + 8), F.tid);
#endif
#if MK_ONE_LAUNCH
#define GSYNC() do { const int l_ = (int)__builtin_amdgcn_mbcnt_hi(~0u, __builtin_amdgcn_mbcnt_lo(~0u, 0u)); xcd_barrier(xbar, F.wave * 64 + l_, (unsigned)F.G); } while (0)
#else
#define GSYNC() do { } while (0)
#endif
#define PHASE(k) do { if (phase_on(k) && p.ph_lo <= (k) && (k) < p.ph_hi) { run_phase<(k)>(F); if ((k) + 1 < p.ph_hi) GSYNC(); } } while (0)
    PHASE(0); PHASE(1); PHASE(2); PHASE(3); PHASE(4); PHASE(5); PHASE(6); PHASE(7); PHASE(8); PHASE(9); PHASE(10); PHASE(11); PHASE(12); PHASE(13); PHASE(14); PHASE(15);
    static_assert(PH_N == 16, "phase list");
}

extern "C" void kernel_launch(void* const* d_in, const int* in_sizes, int n_in, void* d_out, int out_size, void* d_ws, size_t ws_size, hipStream_t stream) {
    static int grid = 0;
    if (grid == 0) {
        if (n_in != 22 || in_sizes[0] != M * DM || out_size != M * DM || ws_size < WS_END) { fprintf(stderr, "kernel_launch: unexpected shapes (n_in %d, in0 %d, out %d, ws %zu)\n", n_in, n_in > 0 ? in_sizes[0] : -1, out_size, ws_size); grid = -1; return; }
        int dev = 0, cus = 0, per_cu = 0;
        (void)hipGetDevice(&dev); (void)hipDeviceGetAttribute(&cus, hipDeviceAttributeMultiprocessorCount, dev);
        if (hipFuncSetAttribute((const void*)mk_fwd, hipFuncAttributeMaxDynamicSharedMemorySize, LDS_BYTES) != hipSuccess) { fprintf(stderr, "kernel_launch: hipFuncSetAttribute failed\n"); grid = -1; return; }
        (void)hipOccupancyMaxActiveBlocksPerMultiprocessor(&per_cu, (const void*)mk_fwd, NTHREADS, LDS_BYTES);
        if (per_cu < 1) { fprintf(stderr, "kernel_launch: occupancy query says %d blocks per CU\n", per_cu); per_cu = 1; }
        (void)hipGetLastError();
        grid = cus;
    }
    if (grid < 0) return;
    Params p{};
    for (int i = 0; i < 22; ++i) p.in[i] = (const float*)d_in[i];
    p.out = (float*)d_out; p.ws = (unsigned char*)d_ws;
#if MK_ONE_LAUNCH
    p.ph_lo = 0; p.ph_hi = PH_N;
    if (hipMemsetAsync((char*)d_ws + WS_CTL, 0, 65536, stream) != hipSuccess) { fprintf(stderr, "kernel_launch: memset failed\n"); return; }
    void* args[] = {&p};
    hipError_t e = hipLaunchCooperativeKernel((const void*)mk_fwd, dim3(grid), dim3(NTHREADS), args, LDS_BYTES, stream);
    if (e != hipSuccess) fprintf(stderr, "cooperative launch failed: %s (grid %d)\n", hipGetErrorString(e), grid);
#else
    for (int ph = 0; ph < PH_N; ++ph) {
        if (!phase_on(ph)) continue;
        p.ph_lo = ph; p.ph_hi = ph + 1;
        hipLaunchKernelGGL(mk_fwd, dim3(grid), dim3(NTHREADS), LDS_BYTES, stream, p);
    }
#endif
}
```

```cpp
#include <hip/hip_runtime.h>
#include <hip/hip_cooperative_groups.h>
#include <cstdio>
#include <cstdint>
namespace cg = cooperative_groups;

#ifndef MK_ONE_LAUNCH
#define MK_ONE_LAUNCH 1
#endif
#ifndef MK_NAIVE
#define MK_NAIVE 0x00
#endif
#ifndef MK_HG_DIRECT
#define MK_HG_DIRECT 0
#endif
constexpr unsigned NAIVE = MK_NAIVE;
constexpr unsigned NV_IN = 1, NV_QKV = 2, NV_ATT = 4, NV_OUT = 8, NV_UP = 16, NV_DOWN = 32;

constexpr int BATCH = 8, SEQ = 2048, DM = 1024, M = BATCH * SEQ;
constexpr int INC = 3136, INCP = 3328;
constexpr int HGW = 512;
constexpr int QRANK = 384, KVRANK = 128, ROPE = 64, NOPE = 128;
constexpr int NQ = 4 * (NOPE + ROPE);
constexpr int NKV = 4 * (NOPE + 128);
constexpr int DFF = 2816, NUP = 2 * DFF;
constexpr float DN_ALPHA = 1.189207115002721f;
constexpr float EPS = 1e-5f;
constexpr float ATT_SCALE = 0.07216878364870322f;

constexpr int PC_Q = 0, PC_V = 512, PC_FF = 1024, PC_FB = 1536, PC_G = 2048, PC_QA = 2560, PC_KVA = 2944, PC_KR = 3072;

constexpr size_t MiB = 1u << 20;
constexpr size_t WS_CTL = 0;
constexpr size_t WS_WIN = 1 * MiB;
constexpr size_t WS_WQB = WS_WIN + (size_t)INCP * DM * 2;
constexpr size_t WS_WKVB = WS_WQB + (size_t)NQ * QRANK * 2;
constexpr size_t WS_WOUT = WS_WKVB + (size_t)NKV * KVRANK * 2;
constexpr size_t WS_WUP = WS_WOUT + (size_t)DM * DM * 2;
constexpr size_t WS_WDN = WS_WUP + (size_t)NUP * DM * 2;
constexpr size_t WS_WEND = WS_WDN + (size_t)DM * DFF * 2;
static_assert(WS_WEND <= 27 * MiB, "weights");
constexpr size_t WS_COS = 27 * MiB, WS_SIN = 29 * MiB;
constexpr size_t WS_MU0 = 31 * MiB, WS_RS0 = WS_MU0 + 65536, WS_LBF = WS_RS0 + 65536, WS_LBB = WS_LBF + 2048;
constexpr size_t WS_SSQQ = WS_LBB + 2048, WS_SSQKV = WS_SSQQ + (size_t)M * 8 * 4;
static_assert(WS_SSQKV + (size_t)M * 4 * 4 <= 32 * MiB, "small");
constexpr size_t WS_XN = 32 * MiB, WS_MIXA = 32 * MiB;
constexpr size_t WS_QHG = 64 * MiB, WS_VHG = 80 * MiB, WS_GATE = 96 * MiB;
constexpr size_t WS_FF = 112 * MiB, WS_FB = 144 * MiB;
constexpr size_t WS_QA = 176 * MiB, WS_KVA = 188 * MiB, WS_KPE = 192 * MiB;
constexpr size_t WS_QAT = 194 * MiB, WS_KV = 218 * MiB;
constexpr size_t WS_Y = 64 * MiB;
constexpr size_t WS_H1B = 128 * MiB;
constexpr size_t WS_ACT = 160 * MiB;
constexpr size_t WS_HALO = 248 * MiB;
constexpr size_t WS_UH = 32 * MiB;
constexpr size_t WS_END = 254 * MiB;
static_assert(WS_HALO + (size_t)64 * 4 * NUP * 4 <= WS_END, "halo");
static_assert(WS_UH + (size_t)8192 * NUP * 2 <= WS_H1B, "uh");

constexpr int LDS_BYTES = 147456;
constexpr int RING_BYTES = 131072;
constexpr int LDS_BND = RING_BYTES;
constexpr int LDS_MISC = RING_BYTES + 8192;
constexpr int NTHREADS = 512;

#define LAS __attribute__((address_space(3)))
typedef unsigned short bf16_t;
typedef short bf16x8 __attribute__((ext_vector_type(8)));
typedef float f32x4 __attribute__((ext_vector_type(4)));
typedef float f32x2 __attribute__((ext_vector_type(2)));
typedef float f32x16 __attribute__((ext_vector_type(16)));
typedef unsigned u32x4 __attribute__((ext_vector_type(4)));
typedef unsigned u32x2 __attribute__((ext_vector_type(2)));
typedef short s16x4 __attribute__((ext_vector_type(4)));

__device__ __forceinline__ float bf2f(bf16_t h) { return __uint_as_float(((unsigned)h) << 16); }
__device__ __forceinline__ unsigned cvt_pk_bf16(float lo, float hi) { unsigned r; asm volatile("v_cvt_pk_bf16_f32 %0, %1, %2" : "=v"(r) : "v"(lo), "v"(hi)); return r; }
__device__ __forceinline__ float sigmoidf_(float x) { return 1.0f / (1.0f + __expf(-x)); }
__device__ __forceinline__ float siluf_(float x) { return x * sigmoidf_(x); }
__device__ __forceinline__ float gelu_tanh(float x) {
    const float z = 1.5957691216057308f * (x + 0.044715f * x * x * x);
    return x / (1.0f + __expf(-z));
}
__device__ __forceinline__ float wave_sum(float v) {
#pragma unroll
    for (int o = 1; o < 64; o <<= 1) v += __shfl_xor(v, o);
    return v;
}
__device__ __forceinline__ float wave_max(float v) {
#pragma unroll
    for (int o = 1; o < 64; o <<= 1) v = fmaxf(v, __shfl_xor(v, o));
    return v;
}

struct Params {
    const float* in[22];
    float* out;
    unsigned char* ws;
    int ph_lo, ph_hi;
};
enum { I_X = 0, I_POS, I_LNG, I_LNB, I_WIN, I_LBF, I_LBB, I_HGG, I_QAG, I_WQB, I_KVG, I_WKVB, I_ATG, I_WOUT, I_L1G, I_L1B, I_WUP, I_CW, I_CB, I_WDN, I_L2G, I_L2B };

struct RowP { float a, b; };

namespace pg8 {
constexpr int BM = 256, BK = 64, HALF = 128, HTB = HALF * BK * 2, STAGE_BYTES = 8 * HTB, NXCD = 8, WGM = 8;
__host__ __device__ __forceinline__ int lds_byte(int r, int c) { const int st = (r >> 4) * 2 + (c >> 5), rr = r & 15, cc = c & 31, ob = rr * 64 + cc * 2; return st * 1024 + (ob ^ (((ob >> 9) & 1) << 5)); }
__host__ __device__ __forceinline__ void stage_rc(int b, int& R, int& C) { const int st = b / 1024, sb = b % 1024, swz = sb ^ (((sb >> 9) & 1) << 5); R = (st >> 1) * 16 + swz / 64; C = (st & 1) * 32 + (swz % 64) / 2; }
__host__ __device__ __forceinline__ int perm32(int rho) { const int n = rho >> 4, i = rho & 15; return 8 * (i >> 2) + 4 * n + (i & 3); }

struct Unit { int pm, pn; };
struct Gemm { const bf16_t* A; const bf16_t* Bt; int M, N, K; };

template <int MM, int NN> struct StaticOrder {
    static constexpr int nM = MM / BM, nN = NN / BM, nwg = nM * nN; int G, c;
    __host__ __device__ void init(int G_, int c_) { G = G_; c = c_; }
    __host__ __device__ bool next(int i, Unit& u) const {
        const long L = (long)i * G + c; if (L >= nwg) return false;
        int wgid = (int)L; { const int q = nwg / NXCD, r = nwg % NXCD, xcd = wgid % NXCD, off = wgid / NXCD; wgid = (xcd < r ? xcd * (q + 1) : r * (q + 1) + (xcd - r) * q) + off; }
        const int nig = WGM * nN, gid = wgid / nig, fm = gid * WGM, gsz = (nM - fm) < WGM ? (nM - fm) : WGM;
        u.pm = fm + ((wgid % nig) % gsz); u.pn = (wgid % nig) / gsz; return true;
    }
    __device__ __forceinline__ void a_ready(const Unit&) const {}
    __device__ __forceinline__ void done(const Unit&) const {}
};

template <int KK, class Epi, class Sched, bool ALIGN_EPI = false, bool SP2 = false>
__device__ __forceinline__ void gemm_phase(LAS unsigned char* lds, int tid_in, const Gemm g, const Sched& S, const Epi& E) {
    const int tid = tid_in, wid = __builtin_amdgcn_readfirstlane(tid >> 6), lane = tid & 63, wr = wid >> 2, wc = wid & 3, fr = lane & 15, fq = lane >> 4;
    constexpr int K = KK, nt = K / BK;
    unsigned voffA[2], voffB[2];
#pragma unroll
    for (int i = 0; i < 2; ++i) { int R, C; stage_rc(tid * 16 + i * 8192, R, C); const int Rb = Epi::PERM ? ((R & ~31) + perm32(R & 31)) : R;
        voffA[i] = (unsigned)(R * K + C) * 2u; voffB[i] = (unsigned)(Rb * K + C) * 2u; }
    constexpr size_t kstep = (size_t)(BK * 2);
    constexpr size_t hstep = (size_t)HALF * K * 2;
    constexpr size_t tstep = 2 * hstep;
    const unsigned ldsw = (unsigned)wid * 1024u;
    const int aoff = lds_byte(wr * 64 + fr, fq * 8), boff = lds_byte(wc * 32 + fr, fq * 8);
#define PG8_SA(b, h) (((b) * 2 + (h)) * HTB)
#define PG8_SB(b, h) ((4 + (b) * 2 + (h)) * HTB)
#define PG8_STAGE(bufoff, gbase, voff) do { _Pragma("unroll") for (int _i = 0; _i < 2; ++_i) \
        __builtin_amdgcn_global_load_lds((const unsigned*)((const char*)(gbase) + (voff)[_i]), (LAS unsigned*)(lds + (bufoff) + ldsw + _i * 8192), 16, 0, 0); } while (0)
#define PG8_LDA(dst, b, h) do { _Pragma("unroll") for (int m = 0; m < 4; ++m) _Pragma("unroll") for (int k = 0; k < 2; ++k) dst[m][k] = *(const LAS bf16x8*)(lds + PG8_SA(b, h) + aoff + m * 2048 + k * 1024); } while (0)
#define PG8_LDB(dst, b, h) do { _Pragma("unroll") for (int n = 0; n < 2; ++n) _Pragma("unroll") for (int k = 0; k < 2; ++k) dst[n][k] = *(const LAS bf16x8*)(lds + PG8_SB(b, h) + boff + n * 2048 + k * 1024); } while (0)
#define PG8_MMA(ai, bj, At, Bt) do { __builtin_amdgcn_s_setprio(1); _Pragma("unroll") for (int m = 0; m < 4; ++m) _Pragma("unroll") for (int n = 0; n < 2; ++n) _Pragma("unroll") for (int k = 0; k < 2; ++k) \
        acc[ai][bj][m][n] = __builtin_amdgcn_mfma_f32_16x16x32_bf16(Bt[n][k], At[m][k], acc[ai][bj][m][n], 0, 0, 0); __builtin_amdgcn_s_setprio(0); } while (0)
#define PG8_WAIT_V(n) asm volatile("s_waitcnt vmcnt(" #n ")" ::: "memory")
#define PG8_WAIT_L(n) asm volatile("s_waitcnt lgkmcnt(" #n ")" ::: "memory")
#define PG8_BAR __builtin_amdgcn_s_barrier()
#define PG8_SCHED __builtin_amdgcn_sched_barrier(0)
    Unit cur, nxt; int ui = 0;
    if (!S.next(0, cur)) return;
    f32x4 acc[2][2][4][2];
#pragma unroll
    for (int a = 0; a < 2; ++a)
#pragma unroll
        for (int b = 0; b < 2; ++b)
#pragma unroll
            for (int m = 0; m < 4; ++m)
#pragma unroll
                for (int n = 0; n < 2; ++n) acc[a][b][m][n] = (f32x4){0.f, 0.f, 0.f, 0.f};
    bf16x8 At[4][2], B0[2][2], B1[2][2];
    const char* cA = (const char*)g.A + (size_t)cur.pm * tstep; const char* cB = (const char*)g.Bt + (size_t)cur.pn * tstep;
    S.a_ready(cur);
    if constexpr (SP2) {
        PG8_STAGE(PG8_SB(0, 0), cB, voffB); PG8_STAGE(PG8_SB(0, 1), cB + hstep, voffB); PG8_STAGE(PG8_SA(0, 0), cA, voffA); PG8_STAGE(PG8_SA(0, 1), cA + hstep, voffA);
        if (wr == 1) PG8_BAR;
        PG8_WAIT_V(2); PG8_BAR;
        PG8_STAGE(PG8_SB(1, 0), cB + kstep, voffB); PG8_STAGE(PG8_SA(1, 0), cA + kstep, voffA); PG8_STAGE(PG8_SB(1, 1), cB + hstep + kstep, voffB);
        PG8_WAIT_V(6); PG8_BAR;
    } else {
        PG8_STAGE(PG8_SB(0, 0), cB, voffB); PG8_STAGE(PG8_SA(0, 0), cA, voffA); PG8_STAGE(PG8_SB(0, 1), cB + hstep, voffB); PG8_STAGE(PG8_SA(0, 1), cA + hstep, voffA);
        if (wr == 1) PG8_BAR;
        PG8_WAIT_V(4); PG8_BAR;
        PG8_STAGE(PG8_SB(1, 0), cB + kstep, voffB); PG8_STAGE(PG8_SA(1, 0), cA + kstep, voffA); PG8_STAGE(PG8_SB(1, 1), cB + hstep + kstep, voffB);
        PG8_WAIT_V(6); PG8_BAR;
    }
    for (;;) {
        const bool has_next = S.next(ui + 1, nxt);
        const char* nA = has_next ? (const char*)g.A + (size_t)nxt.pm * tstep : cA; const char* nB = has_next ? (const char*)g.Bt + (size_t)nxt.pn * tstep : cB;
#pragma unroll 1
        for (int t = 0; t < nt; t += 2) {
            const bool last = (t == nt - 2);
            const char* a1 = cA + (size_t)(t + 1) * kstep;
            const char* a2 = last ? nA : cA + (size_t)(t + 2) * kstep; const char* b2 = last ? nB : cB + (size_t)(t + 2) * kstep;
            const char* a3 = a2 + kstep; const char* b3 = b2 + kstep;
            if (last && has_next) S.a_ready(nxt);
            if constexpr (SP2) {
            PG8_LDB(B0, 0, 0); PG8_LDB(B1, 0, 1); PG8_SCHED; PG8_LDA(At, 0, 0); PG8_STAGE(PG8_SA(1, 1), a1 + hstep, voffA);
            PG8_WAIT_V(8); PG8_WAIT_L(0); PG8_BAR; PG8_MMA(0, 0, At, B0); PG8_MMA(0, 1, At, B1); PG8_BAR; PG8_SCHED;
            PG8_LDA(At, 0, 1); PG8_STAGE(PG8_SB(0, 0), b2, voffB); PG8_STAGE(PG8_SB(0, 1), b2 + hstep, voffB); PG8_STAGE(PG8_SA(0, 0), a2, voffA);
            PG8_WAIT_V(8); PG8_WAIT_L(0); PG8_BAR; PG8_MMA(1, 0, At, B0); PG8_MMA(1, 1, At, B1); PG8_BAR; PG8_SCHED;
            PG8_LDB(B0, 1, 0); PG8_LDB(B1, 1, 1); PG8_SCHED; PG8_LDA(At, 1, 0); PG8_STAGE(PG8_SA(0, 1), a2 + hstep, voffA);
            PG8_WAIT_V(8); PG8_WAIT_L(0); PG8_BAR; PG8_MMA(0, 0, At, B0); PG8_MMA(0, 1, At, B1); PG8_BAR; PG8_SCHED;
            PG8_LDA(At, 1, 1); PG8_STAGE(PG8_SB(1, 0), b3, voffB); PG8_STAGE(PG8_SB(1, 1), b3 + hstep, voffB); PG8_STAGE(PG8_SA(1, 0), a3, voffA);
            PG8_WAIT_V(8); PG8_WAIT_L(0); PG8_BAR; PG8_MMA(1, 0, At, B0); PG8_MMA(1, 1, At, B1); PG8_BAR; PG8_SCHED;
            } else {
            PG8_LDB(B0, 0, 0); PG8_SCHED; PG8_LDA(At, 0, 0); PG8_STAGE(PG8_SA(1, 1), a1 + hstep, voffA);
            PG8_WAIT_L(8); PG8_BAR; PG8_WAIT_L(0); PG8_MMA(0, 0, At, B0); PG8_BAR; PG8_SCHED;
            PG8_LDB(B1, 0, 1); PG8_STAGE(PG8_SB(0, 0), b2, voffB);
            PG8_BAR; PG8_WAIT_L(0); PG8_MMA(0, 1, At, B1); PG8_BAR;
            PG8_LDA(At, 0, 1); PG8_STAGE(PG8_SA(0, 0), a2, voffA);
            PG8_BAR; PG8_WAIT_L(0); PG8_MMA(1, 0, At, B0); PG8_BAR; PG8_SCHED;
            PG8_STAGE(PG8_SB(0, 1), b2 + hstep, voffB);
            PG8_WAIT_V(6); PG8_BAR; PG8_MMA(1, 1, At, B1); PG8_BAR;
            PG8_LDB(B0, 1, 0); PG8_SCHED; PG8_LDA(At, 1, 0); PG8_STAGE(PG8_SA(0, 1), a2 + hstep, voffA);
            PG8_WAIT_L(8); PG8_BAR; PG8_WAIT_L(0); PG8_MMA(0, 0, At, B0); PG8_BAR; PG8_SCHED;
            PG8_LDB(B1, 1, 1); PG8_STAGE(PG8_SB(1, 0), b3, voffB);
            PG8_BAR; PG8_WAIT_L(0); PG8_MMA(0, 1, At, B1); PG8_BAR;
            PG8_LDA(At, 1, 1); PG8_STAGE(PG8_SA(1, 0), a3, voffA);
            PG8_BAR; PG8_WAIT_L(0); PG8_MMA(1, 0, At, B0); PG8_BAR; PG8_SCHED;
            PG8_STAGE(PG8_SB(1, 1), b3 + hstep, voffB);
            PG8_WAIT_V(6); PG8_BAR; PG8_MMA(1, 1, At, B1); PG8_BAR;
            }
        }
        if constexpr (ALIGN_EPI) { if (wr == 0) PG8_BAR; }
        if constexpr (!Epi::AFTER_DRAIN) { E(acc, cur, wr, wc, fr, fq); S.done(cur); }
        if (!has_next) break;
#pragma unroll
        for (int a = 0; a < 2; ++a)
#pragma unroll
            for (int b = 0; b < 2; ++b)
#pragma unroll
                for (int m = 0; m < 4; ++m)
#pragma unroll
                    for (int n = 0; n < 2; ++n) acc[a][b][m][n] = (f32x4){0.f, 0.f, 0.f, 0.f};
        cur = nxt; cA = nA; cB = nB; ++ui;
        if constexpr (ALIGN_EPI) { if (wr == 1) PG8_BAR; }
    }
    PG8_WAIT_V(0);
    if constexpr (!ALIGN_EPI) { if (wr == 0) PG8_BAR; }
    PG8_BAR;
    if constexpr (Epi::AFTER_DRAIN) { E.fused(acc, cur, wr, wc, fr, fq, lds, wid, lane); S.done(cur); }
#undef PG8_SA
#undef PG8_SB
#undef PG8_STAGE
#undef PG8_LDA
#undef PG8_LDB
#undef PG8_MMA
#undef PG8_WAIT_V
#undef PG8_WAIT_L
#undef PG8_BAR
#undef PG8_SCHED
}

template <class Q> struct EpiQuad {
    static constexpr bool PERM = false, AFTER_DRAIN = false; Q q;
    __device__ __forceinline__ void operator()(const f32x4 (&acc)[2][2][4][2], const Unit& u, int wr, int wc, int fr, int fq) const {
#pragma unroll
        for (int ai = 0; ai < 2; ++ai)
#pragma unroll
            for (int m = 0; m < 4; ++m) { const int r = u.pm * BM + ai * HALF + wr * 64 + m * 16 + fr; const RowP rp = q.row_prep(r);
#pragma unroll
                for (int bj = 0; bj < 2; ++bj)
#pragma unroll
                    for (int n = 0; n < 2; ++n) q.quad(r, u.pn * BM + bj * HALF + wc * 32 + n * 16 + fq * 4, acc[ai][bj][m][n], rp);
                asm volatile("" ::: "memory"); }
    }
};
}

__device__ __forceinline__ void st_bf16x4(bf16_t* p, f32x4 v) { u32x2 w; w.x = cvt_pk_bf16(v[0], v[1]); w.y = cvt_pk_bf16(v[2], v[3]); *(u32x2*)p = w; }
__device__ __forceinline__ f32x4 rope4(f32x4 v, const float* cosr, const float* sinr, int i0) {
    const float c0 = cosr[i0], s0 = sinr[i0], c1 = cosr[i0 + 1], s1 = sinr[i0 + 1];
    return (f32x4){v[0] * c0 - v[1] * s0, v[1] * c0 + v[0] * s0, v[2] * c1 - v[3] * s1, v[3] * c1 + v[2] * s1};
}

struct QInProj {
    bf16_t *QHG, *VHG, *GATE, *QA, *KVA, *KPE; float *FF, *FB; const float *LBF, *LBB, *COS, *SIN;
    __device__ __forceinline__ RowP row_prep(int) const { return RowP{0.f, 0.f}; }
    __device__ __forceinline__ void quad(int r, int c, f32x4 v, RowP) const {
        if (c < PC_V) { st_bf16x4(QHG + (size_t)r * HGW + c, (f32x4){siluf_(v[0]), siluf_(v[1]), siluf_(v[2]), siluf_(v[3])}); }
        else if (c < PC_FF) { st_bf16x4(VHG + (size_t)r * HGW + (c - PC_V), v); }
        else if (c < PC_G) { const bool fw = c < PC_FB; const int cc = c - (fw ? PC_FF : PC_FB); const f32x4 lb = *(const f32x4*)((fw ? LBF : LBB) + cc);
            f32x4 f;
#pragma unroll
            for (int j = 0; j < 4; ++j) f[j] = lb[j] + (1.0f - lb[j]) * sigmoidf_(v[j]);
            *(f32x4*)((fw ? FF : FB) + (size_t)r * HGW + cc) = f; }
        else if (c < PC_QA) { st_bf16x4(GATE + (size_t)r * HGW + (c - PC_G), (f32x4){siluf_(v[0]), siluf_(v[1]), siluf_(v[2]), siluf_(v[3])}); }
        else if (c < PC_KVA) { st_bf16x4(QA + (size_t)r * QRANK + (c - PC_QA), v); }
        else if (c < PC_KR) { st_bf16x4(KVA + (size_t)r * KVRANK + (c - PC_KVA), v); }
        else if (c < INC) { const int e = c - PC_KR; st_bf16x4(KPE + (size_t)r * ROPE + e, rope4(v, COS + (size_t)r * 32, SIN + (size_t)r * 32, e >> 1)); }
    }
};
struct QQb {
    bf16_t* QAT; const float *SSQQ, *COS, *SIN;
    __device__ __forceinline__ RowP row_prep(int r) const { const f32x4 a = *(const f32x4*)(SSQQ + (size_t)r * 8), b = *(const f32x4*)(SSQQ + (size_t)r * 8 + 4);
        const float s = ((a[0] + a[1]) + (a[2] + a[3])) + ((b[0] + b[1]) + (b[2] + b[3])); return RowP{1.0f / sqrtf(s * (1.0f / QRANK) + EPS), 0.f}; }
    __device__ __forceinline__ void quad(int r, int c, f32x4 v, RowP rp) const {
        v = v * rp.a; const int d = c % 192;
        if (d >= NOPE) v = rope4(v, COS + (size_t)r * 32, SIN + (size_t)r * 32, (d - NOPE) >> 1);
        st_bf16x4(QAT + (size_t)r * NQ + c, v);
    }
};
struct QKvb {
    bf16_t* KV; const float* SSQKV;
    __device__ __forceinline__ RowP row_prep(int r) const { const f32x4 a = *(const f32x4*)(SSQKV + (size_t)r * 4);
        return RowP{1.0f / sqrtf(((a[0] + a[1]) + (a[2] + a[3])) * (1.0f / KVRANK) + EPS), 0.f}; }
    __device__ __forceinline__ void quad(int r, int c, f32x4 v, RowP rp) const { st_bf16x4(KV + (size_t)r * NKV + c, v * rp.a); }
};
struct QOut {
    float* Y; const float *X, *MU0, *RS0, *G, *Bv;
    __device__ __forceinline__ RowP row_prep(int r) const { return RowP{MU0[r], RS0[r]}; }
    __device__ __forceinline__ void quad(int r, int c, f32x4 v, RowP rp) const {
        const f32x4 x = *(const f32x4*)(X + (size_t)r * DM + c), g = *(const f32x4*)(G + c), b = *(const f32x4*)(Bv + c);
        const f32x4 h0 = (x - rp.a) * rp.b * g + b;
        *(f32x4*)(Y + (size_t)r * DM + c) = h0 * DN_ALPHA + v;
    }
};
struct QUpNaive {
    bf16_t* UH; int r0;
    __device__ __forceinline__ RowP row_prep(int) const { return RowP{0.f, 0.f}; }
    __device__ __forceinline__ void quad(int r, int c, f32x4 v, RowP) const { st_bf16x4(UH + (size_t)(r - r0) * NUP + c, v); }
};
struct QDown {
    float* Y; const float* H1;
    __device__ __forceinline__ RowP row_prep(int) const { return RowP{0.f, 0.f}; }
    __device__ __forceinline__ void quad(int r, int c, f32x4 v, RowP) const {
        const f32x4 h = *(const f32x4*)(H1 + (size_t)r * DM + c);
        *(f32x4*)(Y + (size_t)r * DM + c) = h * DN_ALPHA + v;
    }
};

struct EpiInProj {
    static constexpr bool PERM = false, AFTER_DRAIN = false; QInProj q; float *SSQQ, *SSQKV;
    __device__ __forceinline__ void operator()(const f32x4 (&acc)[2][2][4][2], const pg8::Unit& u, int wr, int wc, int fr, int fq) const {
        pg8::EpiQuad<QInProj> e{q}; e(acc, u, wr, wc, fr, fq);
        if (u.pn == 10 || u.pn == 11) {
#pragma unroll
            for (int ai = 0; ai < 2; ++ai)
#pragma unroll
                for (int m = 0; m < 4; ++m) { const int r = u.pm * 256 + ai * 128 + wr * 64 + m * 16 + fr; float s[2];
#pragma unroll
                    for (int bj = 0; bj < 2; ++bj) { float t = 0.f;
#pragma unroll
                        for (int n = 0; n < 2; ++n) { const f32x4 x = acc[ai][bj][m][n]; t += (x[0] * x[0] + x[1] * x[1]) + (x[2] * x[2] + x[3] * x[3]); }
                        t += __shfl_xor(t, 16); t += __shfl_xor(t, 32); s[bj] = t; }
                    if (fq == 0) { if (u.pn == 10) SSQQ[(size_t)r * 8 + wc] = s[0] + s[1]; else { SSQQ[(size_t)r * 8 + 4 + wc] = s[0]; SSQKV[(size_t)r * 4 + wc] = s[1]; } } }
        }
    }
};

__device__ __forceinline__ float dpp_ror1(float x) { return __int_as_float(__builtin_amdgcn_update_dpp(0, __float_as_int(x), 0x121, 0xF, 0xF, false)); }
__device__ __forceinline__ float dpp_rol1(float x) { return __int_as_float(__builtin_amdgcn_update_dpp(0, __float_as_int(x), 0x12F, 0xF, 0xF, false)); }
struct EpiConvGlu {
    static constexpr bool PERM = true, AFTER_DRAIN = false;
    bf16_t* ACT; float* HALO; const float* CW; const float* CBv; LAS float* bnd;
    __device__ __forceinline__ void operator()(const f32x4 (&acc)[2][2][4][2], const pg8::Unit& u, int wr, int wc, int fr, int fq) const {
        const int chl = wc * 32 + fq * 8;
#pragma unroll
        for (int ai = 0; ai < 2; ++ai) { const int gq = 2 * ai + wr;
            if (fr == 0) {
#pragma unroll
                for (int bj = 0; bj < 2; ++bj)
#pragma unroll
                    for (int n = 0; n < 2; ++n) *(LAS f32x4*)(bnd + ((gq * 2 + 0) * 2 + bj) * 128 + chl + 4 * n) = acc[ai][bj][0][n]; }
            if (fr == 15) {
#pragma unroll
                for (int bj = 0; bj < 2; ++bj)
#pragma unroll
                    for (int n = 0; n < 2; ++n) *(LAS f32x4*)(bnd + ((gq * 2 + 1) * 2 + bj) * 128 + chl + 4 * n) = acc[ai][bj][3][n]; } }
        if (wr == 0 && fr < 2) {
#pragma unroll
            for (int bj = 0; bj < 2; ++bj)
#pragma unroll
                for (int n = 0; n < 2; ++n) *(f32x4*)(HALO + ((size_t)u.pm * 4 + fr) * NUP + bj * DFF + u.pn * 128 + chl + 4 * n) = acc[0][bj][0][n]; }
        if (wr == 1 && fr >= 14) {
#pragma unroll
            for (int bj = 0; bj < 2; ++bj)
#pragma unroll
                for (int n = 0; n < 2; ++n) *(f32x4*)(HALO + ((size_t)u.pm * 4 + (fr - 12)) * NUP + bj * DFF + u.pn * 128 + chl + 4 * n) = acc[1][bj][3][n]; }
        asm volatile("s_waitcnt lgkmcnt(0)" ::: "memory"); __builtin_amdgcn_s_barrier(); asm volatile("" ::: "memory");
        unsigned outw[2][4][4];
#pragma unroll
        for (int ai = 0; ai < 2; ++ai) { const int gq = 2 * ai + wr;
#pragma unroll
          for (int n = 0; n < 2; ++n)
#pragma unroll
            for (int jp = 0; jp < 2; ++jp) {
                float val[2][4];
#pragma unroll
                for (int jj = 0; jj < 2; ++jj) { const int j = 2 * jp + jj, cl = chl + 4 * n + j, ch = u.pn * 128 + cl;
                    const float wa0 = CW[ch], wa1 = CW[NUP + ch], wa2 = CW[2 * NUP + ch], ba = CBv[ch];
                    const float wb0 = CW[DFF + ch], wb1 = CW[NUP + DFF + ch], wb2 = CW[2 * NUP + DFF + ch], bb = CBv[DFF + ch];
                    const float pbA = gq > 0 ? bnd[(((gq - 1) * 2 + 1) * 2 + 0) * 128 + cl] : 0.f, pbB = gq > 0 ? bnd[(((gq - 1) * 2 + 1) * 2 + 1) * 128 + cl] : 0.f;
                    const float nbA = gq < 3 ? bnd[(((gq + 1) * 2 + 0) * 2 + 0) * 128 + cl] : 0.f, nbB = gq < 3 ? bnd[(((gq + 1) * 2 + 0) * 2 + 1) * 128 + cl] : 0.f;
                    float xa[4], xb[4], Ra[4], La[4], Rb[4], Lb[4];
#pragma unroll
                    for (int m = 0; m < 4; ++m) { xa[m] = acc[ai][0][m][n][j]; xb[m] = acc[ai][1][m][n][j]; Ra[m] = dpp_ror1(xa[m]); La[m] = dpp_rol1(xa[m]); Rb[m] = dpp_ror1(xb[m]); Lb[m] = dpp_rol1(xb[m]); }
#pragma unroll
                    for (int m = 0; m < 4; ++m) {
                        const float pa = fr > 0 ? Ra[m] : (m > 0 ? Ra[m > 0 ? m - 1 : 0] : pbA), pb = fr > 0 ? Rb[m] : (m > 0 ? Rb[m > 0 ? m - 1 : 0] : pbB);
                        const float na = fr < 15 ? La[m] : (m < 3 ? La[m < 3 ? m + 1 : 3] : nbA), nb = fr < 15 ? Lb[m] : (m < 3 ? Lb[m < 3 ? m + 1 : 3] : nbB);
                        const float ca = wa0 * pa + wa1 * xa[m] + wa2 * na + ba, cb = wb0 * pb + wb1 * xb[m] + wb2 * nb + bb;
                        val[jj][m] = gelu_tanh(ca) * cb; } }
#pragma unroll
                for (int m = 0; m < 4; ++m) outw[ai][m][n * 2 + jp] = cvt_pk_bf16(val[0][m], val[1][m]);
            } }
#pragma unroll
        for (int ai = 0; ai < 2; ++ai)
#pragma unroll
            for (int m = 0; m < 4; ++m) { const int tr = ai * 128 + wr * 64 + m * 16 + fr;
                if (tr != 0 && tr != 255) *(u32x4*)(ACT + (size_t)(u.pm * 256 + tr) * DFF + u.pn * 128 + chl) = (u32x4){outw[ai][m][0], outw[ai][m][1], outw[ai][m][2], outw[ai][m][3]}; }
    }
};

template <class Q>
__device__ __forceinline__ void naive_gemm(LAS unsigned char* lds, int tid, const bf16_t* A, int lda, const bf16_t* Bt, int ldb, int row0, int nrows, int N, int K, const Q& q) {
    LAS float* As = (LAS float*)lds;
    LAS float* Bs = As + 16 * 132;
    const int ty = tid >> 4, tx = tid & 15;
    const int tiles_n = N / 64, ntiles = (nrows / 128) * tiles_n;
    for (int t = blockIdx.x; t < ntiles; t += gridDim.x) {
        const int tm = t / tiles_n, tn = t % tiles_n;
        float acc[4][4];
#pragma unroll
        for (int i = 0; i < 4; ++i)
#pragma unroll
            for (int j = 0; j < 4; ++j) acc[i][j] = 0.f;
        for (int k0 = 0; k0 < K; k0 += 16) {
            { const int row = tid >> 2, kk = (tid & 3) * 4; const ushort4 v = *(const ushort4*)(A + (size_t)(row0 + tm * 128 + row) * lda + k0 + kk);
              As[(kk + 0) * 132 + row] = bf2f(v.x); As[(kk + 1) * 132 + row] = bf2f(v.y); As[(kk + 2) * 132 + row] = bf2f(v.z); As[(kk + 3) * 132 + row] = bf2f(v.w); }
            if (tid < 256) { const int n = tid >> 2, kk = (tid & 3) * 4; const ushort4 v = *(const ushort4*)(Bt + (size_t)(tn * 64 + n) * ldb + k0 + kk);
              Bs[(kk + 0) * 68 + n] = bf2f(v.x); Bs[(kk + 1) * 68 + n] = bf2f(v.y); Bs[(kk + 2) * 68 + n] = bf2f(v.z); Bs[(kk + 3) * 68 + n] = bf2f(v.w); }
            __syncthreads();
#pragma unroll
            for (int kk = 0; kk < 16; ++kk) {
                const f32x4 a = *(const LAS f32x4*)(As + kk * 132 + ty * 4), b = *(const LAS f32x4*)(Bs + kk * 68 + tx * 4);
#pragma unroll
                for (int i = 0; i < 4; ++i)
#pragma unroll
                    for (int j = 0; j < 4; ++j) acc[i][j] = fmaf(a[i], b[j], acc[i][j]);
            }
            __syncthreads();
        }
#pragma unroll
        for (int i = 0; i < 4; ++i) { const int r = row0 + tm * 128 + ty * 4 + i; const RowP rp = q.row_prep(r); q.quad(r, tn * 64 + tx * 4, (f32x4){acc[i][0], acc[i][1], acc[i][2], acc[i][3]}, rp); }
    }
}

struct Frame {
    LAS unsigned char* lds; int tid, lane, wave, G, bid, vcu;
    const float* const* in; float* out; unsigned char* ws;
};
template <class T> __device__ __forceinline__ T* wsp(const Frame& F, size_t off) { return (T*)(F.ws + off); }

template <class PhysFn>
__device__ __forceinline__ void transpose_item(const float* W, int K, int N, bf16_t* WT, const float* kscale, LAS float* scr, int item, int lane, PhysFn phys) {
    const int nblk = N / 32, kb = item / nblk, nb = item % nblk, k0 = 64 * kb, n0 = 32 * nb;
#pragma unroll 8
    for (int i = 0; i < 32; ++i) { const int kk = 2 * i + (lane >> 5); float w = W[(size_t)(k0 + kk) * N + n0 + (lane & 31)]; if (kscale) w *= kscale[k0 + kk]; scr[kk * 33 + (lane & 31)] = w; }
    asm volatile("s_waitcnt lgkmcnt(0)" ::: "memory");
    const int c = lane & 7;
#pragma unroll
    for (int j = 0; j < 4; ++j) { const int n = (lane >> 3) + 8 * j; const LAS float* s = scr + (8 * c) * 33 + n;
        u32x4 o; o.x = cvt_pk_bf16(s[0 * 33], s[1 * 33]); o.y = cvt_pk_bf16(s[2 * 33], s[3 * 33]); o.z = cvt_pk_bf16(s[4 * 33], s[5 * 33]); o.w = cvt_pk_bf16(s[6 * 33], s[7 * 33]);
        *(u32x4*)(WT + (size_t)phys(n0 + n) * K + k0 + 8 * c) = o; }
    asm volatile("s_waitcnt lgkmcnt(0)" ::: "memory");
}
__device__ __forceinline__ int phys_id(int n) { return n; }
__device__ __forceinline__ int phys_rope64(int e) { return e < 32 ? 2 * e : 2 * (e - 32) + 1; }
__device__ __forceinline__ int phys_win(int n) { return n < PC_KR ? n : PC_KR + phys_rope64(n - PC_KR); }
__device__ __forceinline__ int phys_wqb(int n) { const int h = n / 192, d = n % 192; return h * 192 + (d < NOPE ? d : NOPE + phys_rope64(d - NOPE)); }
__device__ __forceinline__ int phys_wup(int n) { const int j = n < DFF ? n : n - DFF; return (j >> 7) * 256 + (n < DFF ? 0 : 128) + (j & 127); }

__device__ __forceinline__ void p0_prologue(Frame& F) {
    LAS float* scr = (LAS float*)(F.lds + F.wave * 16384);
    const int gw = F.vcu * 8 + F.wave, NGW = F.G * 8;
    bf16_t* WIN = wsp<bf16_t>(F, WS_WIN); bf16_t* WQB = wsp<bf16_t>(F, WS_WQB); bf16_t* WKVB = wsp<bf16_t>(F, WS_WKVB);
    bf16_t* WOUT = wsp<bf16_t>(F, WS_WOUT); bf16_t* WUP = wsp<bf16_t>(F, WS_WUP); bf16_t* WDN = wsp<bf16_t>(F, WS_WDN);
    constexpr int I_IN = (DM / 64) * (INC / 32), I_QB = (QRANK / 64) * (NQ / 32), I_KVB = (KVRANK / 64) * (NKV / 32), I_OUT = (DM / 64) * (DM / 32), I_UP = (DM / 64) * (NUP / 32), I_DN = (DFF / 64) * (DM / 32);
    constexpr int NITEMS = I_IN + I_QB + I_KVB + I_OUT + I_UP + I_DN;
    for (int it = gw; it < NITEMS; it += NGW) {
        int r = it;
        if (r < I_IN) { transpose_item(F.in[I_WIN], DM, INC, WIN, nullptr, scr, r, F.lane, phys_win); continue; } r -= I_IN;
        if (r < I_QB) { transpose_item(F.in[I_WQB], QRANK, NQ, WQB, F.in[I_QAG], scr, r, F.lane, phys_wqb); continue; } r -= I_QB;
        if (r < I_KVB) { transpose_item(F.in[I_WKVB], KVRANK, NKV, WKVB, F.in[I_KVG], scr, r, F.lane, phys_id); continue; } r -= I_KVB;
        if (r < I_OUT) { transpose_item(F.in[I_WOUT], DM, DM, WOUT, nullptr, scr, r, F.lane, phys_id); continue; } r -= I_OUT;
        if (r < I_UP) { transpose_item(F.in[I_WUP], DM, NUP, WUP, nullptr, scr, r, F.lane, phys_wup); continue; } r -= I_UP;
        transpose_item(F.in[I_WDN], DFF, DM, WDN, nullptr, scr, r, F.lane, phys_id);
    }
    { u32x4* z = (u32x4*)(WIN + (size_t)INC * DM); const int n16 = (INCP - INC) * DM * 2 / 16;
      for (int i = F.bid * NTHREADS + F.tid; i < n16; i += F.G * NTHREADS) z[i] = (u32x4){0u, 0u, 0u, 0u}; }
    { bf16_t* XN = wsp<bf16_t>(F, WS_XN); float* MU0 = wsp<float>(F, WS_MU0); float* RS0 = wsp<float>(F, WS_RS0);
      const float* g = F.in[I_LNG]; const float* bb = F.in[I_LNB];
      for (int m = gw; m < M; m += NGW) {
        const f32x4* xr = (const f32x4*)(F.in[I_X] + (size_t)m * DM) + F.lane;
        f32x4 v[4]; float s = 0.f;
#pragma unroll
        for (int j = 0; j < 4; ++j) { v[j] = xr[64 * j]; s += (v[j][0] + v[j][1]) + (v[j][2] + v[j][3]); }
        const float mean = wave_sum(s) * (1.f / DM); float s2 = 0.f;
#pragma unroll
        for (int j = 0; j < 4; ++j) { const f32x4 d = v[j] - mean; s2 += (d[0] * d[0] + d[1] * d[1]) + (d[2] * d[2] + d[3] * d[3]); }
        const float rstd = 1.f / sqrtf(wave_sum(s2) * (1.f / DM) + EPS);
        if (F.lane == 0) { MU0[m] = mean; RS0[m] = rstd; }
#pragma unroll
        for (int j = 0; j < 4; ++j) { const int c = 4 * F.lane + 256 * j; const f32x4 gg = *(const f32x4*)(g + c), bv = *(const f32x4*)(bb + c);
            st_bf16x4(XN + (size_t)m * DM + c, (v[j] - mean) * rstd * gg + bv); }
      } }
    { float* COS = wsp<float>(F, WS_COS); float* SIN = wsp<float>(F, WS_SIN); const int* pos = (const int*)F.in[I_POS];
      for (int i = F.bid * NTHREADS + F.tid; i < M * 32; i += F.G * NTHREADS) { const int m = i >> 5, k = i & 31;
        const float invf = 1.0f / powf(10000.0f, (float)k * (1.0f / 32.0f));
        const float ang = (float)pos[m] * invf;
        const double rev = (double)ang * 0.15915494309189535; const float fr = (float)(rev - floor(rev));
        COS[i] = __builtin_amdgcn_cosf(fr); SIN[i] = __builtin_amdgcn_sinf(fr); }
      float* LBF = wsp<float>(F, WS_LBF); float* LBB = wsp<float>(F, WS_LBB);
      for (int i = F.bid * NTHREADS + F.tid; i < 2 * HGW; i += F.G * NTHREADS) { const bool fw = i < HGW; const int c = fw ? i : i - HGW; const float* lb = fw ? F.in[I_LBF] : F.in[I_LBB];
        const float v = 1.0f / (1.0f + __expf(lb[HGW + c] - lb[c])); (fw ? LBF : LBB)[c] = v; } }
}

__device__ __forceinline__ void p_ssq_naive(Frame& F) {
    const bf16_t* QA = wsp<bf16_t>(F, WS_QA); const bf16_t* KVA = wsp<bf16_t>(F, WS_KVA); float* SSQQ = wsp<float>(F, WS_SSQQ); float* SSQKV = wsp<float>(F, WS_SSQKV);
    const int gw = F.bid * 8 + F.wave, NGW = F.G * 8;
    for (int m = gw; m < M; m += NGW) {
        float s = 0.f;
        for (int c = F.lane; c < QRANK; c += 64) { const float v = bf2f(QA[(size_t)m * QRANK + c]); s += v * v; }
        s = wave_sum(s);
        float t = 0.f;
        for (int c = F.lane; c < KVRANK; c += 64) { const float v = bf2f(KVA[(size_t)m * KVRANK + c]); t += v * v; }
        t = wave_sum(t);
        if (F.lane < 8) SSQQ[(size_t)m * 8 + F.lane] = F.lane == 0 ? s : 0.f;
        if (F.lane < 4) SSQKV[(size_t)m * 4 + F.lane] = F.lane == 0 ? t : 0.f;
    }
}

__device__ __forceinline__ void p_attn_naive(Frame& F) {
    const bf16_t* QAT = wsp<bf16_t>(F, WS_QAT); const bf16_t* KV = wsp<bf16_t>(F, WS_KV); const bf16_t* KPE = wsp<bf16_t>(F, WS_KPE); bf16_t* MIXA = wsp<bf16_t>(F, WS_MIXA);
    const float* g = F.in[I_ATG];
    LAS float* qs = (LAS float*)F.lds + F.wave * 192;
    LAS float* ps = (LAS float*)(F.lds + 8192) + F.wave * 2048;
    const int gw = F.bid * 8 + F.wave, NGW = F.G * 8;
    for (int item = gw; item < M * 4; item += NGW) {
        const int b = item / (4 * SEQ), h = (item / SEQ) % 4, t = item % SEQ; const size_t m = (size_t)b * SEQ + t;
        for (int d = F.lane; d < 192; d += 64) qs[d] = bf2f(QAT[m * NQ + h * 192 + d]);
        asm volatile("s_waitcnt lgkmcnt(0)" ::: "memory");
        float mx = -1e30f;
#pragma unroll 1
        for (int i = 0; i < 32; ++i) { const size_t kr = (size_t)b * SEQ + F.lane + 64 * i; float s = 0.f;
            const bf16_t* kn = KV + kr * NKV + h * 256;
#pragma unroll 4
            for (int d = 0; d < 128; d += 8) { const bf16x8 kv = *(const bf16x8*)(kn + d);
#pragma unroll
                for (int j = 0; j < 8; ++j) s = fmaf(qs[d + j], bf2f((bf16_t)kv[j]), s); }
            const bf16_t* kp = KPE + kr * ROPE;
#pragma unroll 4
            for (int d = 0; d < 64; d += 8) { const bf16x8 kv = *(const bf16x8*)(kp + d);
#pragma unroll
                for (int j = 0; j < 8; ++j) s = fmaf(qs[128 + d + j], bf2f((bf16_t)kv[j]), s); }
            s *= ATT_SCALE; ps[F.lane + 64 * i] = s; mx = fmaxf(mx, s); }
        mx = wave_max(mx); float sum = 0.f;
#pragma unroll 1
        for (int i = 0; i < 32; ++i) { const float pv = __expf(ps[F.lane + 64 * i] - mx); sum += pv; ps[F.lane + 64 * i] = pv; }
        sum = wave_sum(sum);
        asm volatile("s_waitcnt lgkmcnt(0)" ::: "memory");
        float o0 = 0.f, o1 = 0.f; const bf16_t* vb = KV + (size_t)b * SEQ * NKV + h * 256 + 128 + 2 * F.lane;
        for (int j = 0; j < SEQ; ++j) { const unsigned w = *(const unsigned*)(vb + (size_t)j * NKV); const float pj = ps[j];
            o0 = fmaf(pj, __uint_as_float(w << 16), o0); o1 = fmaf(pj, __uint_as_float(w & 0xffff0000u), o1); }
        const float inv = 1.0f / sum; o0 *= inv; o1 *= inv;
        const float ss = wave_sum(o0 * o0 + o1 * o1); const float rs = 1.0f / sqrtf(ss * (1.0f / 128.0f) + EPS);
        *(unsigned*)(MIXA + m * DM + 512 + h * 128 + 2 * F.lane) = cvt_pk_bf16(o0 * rs * g[2 * F.lane], o1 * rs * g[2 * F.lane + 1]);
        asm volatile("s_waitcnt lgkmcnt(0)" ::: "memory");
    }
}

__device__ __forceinline__ void p_hgrn_scan(Frame& F) {
    const bf16_t* QHG = wsp<bf16_t>(F, WS_QHG); const bf16_t* VHG = wsp<bf16_t>(F, WS_VHG); const float* FFp = wsp<float>(F, WS_FF); const float* FBp = wsp<float>(F, WS_FB);
    float* OF = F.out; float* OB = F.out + (size_t)M * HGW;
    LAS float* qs = (LAS float*)F.lds;
    LAS float* fs = qs + 32 * 128;
    LAS float* vs_ = fs + 32 * 128;
    LAS float* op = vs_ + 32 * 32;
    const int tid = F.tid, vv = tid & 31, ks = tid >> 5;
    for (int item = F.bid; item < 256; item += F.G) {
        const int vsl = item & 3, dir = (item >> 2) & 1, h = (item >> 3) & 3, b = item >> 5;
        const float* Fp = dir ? FBp : FFp; float* O = dir ? OB : OF;
        float S[8];
#pragma unroll
        for (int j = 0; j < 8; ++j) S[j] = 0.f;
        for (int c = 0; c < SEQ / 32; ++c) {
            { const int i = tid >> 4, k0 = (tid & 15) * 8; const int s = c * 32 + i, t = dir ? SEQ - 1 - s : s; const size_t row = (size_t)b * SEQ + t;
              const bf16x8 qv = *(const bf16x8*)(QHG + row * HGW + h * 128 + k0);
              const f32x4 f0 = *(const f32x4*)(Fp + row * HGW + h * 128 + k0), f1 = *(const f32x4*)(Fp + row * HGW + h * 128 + k0 + 4);
#pragma unroll
              for (int j = 0; j < 8; ++j) qs[i * 128 + k0 + j] = bf2f((bf16_t)qv[j]);
              *(LAS f32x4*)(fs + i * 128 + k0) = f0; *(LAS f32x4*)(fs + i * 128 + k0 + 4) = f1;
              if (tid < 128) { const int i2 = tid >> 2, v0 = (tid & 3) * 8; const int s2 = c * 32 + i2, t2 = dir ? SEQ - 1 - s2 : s2; const size_t row2 = (size_t)b * SEQ + t2;
                const bf16x8 vvv = *(const bf16x8*)(VHG + row2 * HGW + h * 128 + vsl * 32 + v0);
#pragma unroll
                for (int j = 0; j < 8; ++j) vs_[i2 * 32 + v0 + j] = bf2f((bf16_t)vvv[j]); } }
            __syncthreads();
            for (int i = 0; i < 32; ++i) {
                const f32x4 q0 = *(const LAS f32x4*)(qs + i * 128 + ks * 8), q1 = *(const LAS f32x4*)(qs + i * 128 + ks * 8 + 4);
                const f32x4 f0 = *(const LAS f32x4*)(fs + i * 128 + ks * 8), f1 = *(const LAS f32x4*)(fs + i * 128 + ks * 8 + 4);
                const float v = vs_[i * 32 + vv]; float o = 0.f;
#pragma unroll
                for (int j = 0; j < 4; ++j) { S[j] = fmaf(f0[j], S[j] - v, v); o = fmaf(S[j], q0[j], o); S[4 + j] = fmaf(f1[j], S[4 + j] - v, v); o = fmaf(S[4 + j], q1[j], o); }
                o += __shfl_xor(o, 32);
                if (F.lane < 32) op[(F.wave * 32 + i) * 32 + vv] = o;
            }
            __syncthreads();
#pragma unroll
            for (int rr = 0; rr < 2; ++rr) { const int i = (tid >> 5) + 16 * rr; float o = 0.f;
#pragma unroll
                for (int w = 0; w < 8; ++w) o += op[(w * 32 + i) * 32 + vv];
                const int s = c * 32 + i, t = dir ? SEQ - 1 - s : s;
                O[((size_t)b * SEQ + t) * HGW + h * 128 + vsl * 32 + vv] = o; }
            __syncthreads();
        }
    }
}

namespace hg {
constexpr int OFF_QG = 0, OFF_KD = 16384, OFF_KLT = 32768, OFF_ST = 49152, OFF_A = 57344, OFF_VT = 65536, OFF_SEG = 69632, OFF_DL = 71680, LDS_END = 72192;
static_assert(LDS_END <= RING_BYTES, "hgrn LDS");
#define SW256(row, colB) ((row) * 256 + ((colB) ^ (((row) & 7) << 4)))
#define SW128(row, colB) ((row) * 128 + ((colB) ^ (((row) & 7) << 4)))
__device__ __forceinline__ void scan_item(const Frame& F, int item) {
    const bf16_t* QHG = wsp<bf16_t>(F, WS_QHG); const bf16_t* VHG = wsp<bf16_t>(F, WS_VHG);
    const int vsl = item & 3, dir = (item >> 2) & 1, h = (item >> 3) & 3, b = item >> 5;
    const float* Fp = dir ? wsp<float>(F, WS_FB) : wsp<float>(F, WS_FF); float* O = dir ? F.out + (size_t)M * HGW : F.out;
    LAS unsigned char* L = F.lds;
    const int tid = F.tid, lane = F.lane, wid = F.wave, r32 = lane & 31, hi = lane >> 5;
    const int k = tid & 127, tq = tid >> 7;
    const int vt = tid >> 3, v0 = (tid & 7) * 4;
    const size_t colq = (size_t)h * 128 + k, colv = (size_t)h * 128 + vsl * 32 + v0;
    auto rowof = [&](int c, int i) -> size_t { const int s = c * 64 + i; return (size_t)b * SEQ + (dir ? SEQ - 1 - s : s); };
    float f[16]; bf16_t qv[16]; u32x2 vv;
#pragma unroll
    for (int j = 0; j < 16; ++j) { const size_t r = rowof(0, 16 * tq + j); f[j] = Fp[r * HGW + colq]; qv[j] = QHG[r * HGW + colq]; }
    vv = *(const u32x2*)(VHG + rowof(0, vt) * HGW + colv);
    f32x16 Sacc = {};
    for (int c = 0; c < SEQ / 64; ++c) {
        float G[16]; float run = 0.f;
#pragma unroll
        for (int j = 0; j < 16; ++j) { run += __builtin_amdgcn_logf(f[j]); G[j] = run; }
        *(LAS float*)(L + OFF_SEG + (tq * 128 + k) * 4) = run;
        if (wid < 4) {
#pragma unroll
            for (int q4 = 0; q4 < 4; ++q4) { u32x2 w; w.x = cvt_pk_bf16(Sacc[4 * q4 + 0], Sacc[4 * q4 + 1]); w.y = cvt_pk_bf16(Sacc[4 * q4 + 2], Sacc[4 * q4 + 3]);
                *(LAS u32x2*)(L + OFF_ST + SW256(r32, 2 * (32 * wid + 8 * q4 + 4 * hi))) = w; } }
        asm volatile("s_waitcnt lgkmcnt(0)" ::: "memory"); __builtin_amdgcn_s_barrier(); asm volatile("" ::: "memory");
        { const float s0 = *(LAS float*)(L + OFF_SEG + (0 * 128 + k) * 4), s1 = *(LAS float*)(L + OFF_SEG + (1 * 128 + k) * 4), s2 = *(LAS float*)(L + OFF_SEG + (2 * 128 + k) * 4), s3 = *(LAS float*)(L + OFF_SEG + (3 * 128 + k) * 4);
          const float pre = (tq > 0 ? s0 : 0.f) + (tq > 1 ? s1 : 0.f) + (tq > 2 ? s2 : 0.f); const float Gl = (s0 + s1) + (s2 + s3); const float dl = __builtin_amdgcn_exp2f(Gl);
          if (tq == 0) *(LAS float*)(L + OFF_DL + k * 4) = dl;
          float kl[16];
#pragma unroll
          for (int j = 0; j < 16; ++j) { const int t = 16 * tq + j; const float G2 = pre + G[j]; const float eG = __builtin_amdgcn_exp2f(G2), kd = (1.0f - f[j]) * __builtin_amdgcn_exp2f(-G2);
              const float qg = bf2f(qv[j]) * eG; kl[j] = kd * dl;
              *(LAS bf16_t*)(L + OFF_QG + SW256(t, 2 * k)) = (bf16_t)(cvt_pk_bf16(qg, 0.f) & 0xffffu);
              *(LAS bf16_t*)(L + OFF_KD + SW256(t, 2 * k)) = (bf16_t)(cvt_pk_bf16(kd, 0.f) & 0xffffu); }
          u32x4 w0, w1; w0.x = cvt_pk_bf16(kl[0], kl[1]); w0.y = cvt_pk_bf16(kl[2], kl[3]); w0.z = cvt_pk_bf16(kl[4], kl[5]); w0.w = cvt_pk_bf16(kl[6], kl[7]);
          w1.x = cvt_pk_bf16(kl[8], kl[9]); w1.y = cvt_pk_bf16(kl[10], kl[11]); w1.z = cvt_pk_bf16(kl[12], kl[13]); w1.w = cvt_pk_bf16(kl[14], kl[15]);
          *(LAS u32x4*)(L + OFF_KLT + SW128(k, 32 * tq)) = w0; *(LAS u32x4*)(L + OFF_KLT + SW128(k, 32 * tq + 16)) = w1;
          *(LAS bf16_t*)(L + OFF_VT + SW128(v0 + 0, 2 * vt)) = (bf16_t)(vv.x & 0xffffu); *(LAS bf16_t*)(L + OFF_VT + SW128(v0 + 1, 2 * vt)) = (bf16_t)(vv.x >> 16);
          *(LAS bf16_t*)(L + OFF_VT + SW128(v0 + 2, 2 * vt)) = (bf16_t)(vv.y & 0xffffu); *(LAS bf16_t*)(L + OFF_VT + SW128(v0 + 3, 2 * vt)) = (bf16_t)(vv.y >> 16); }
        if (c + 1 < SEQ / 64) {
#pragma unroll
            for (int j = 0; j < 16; ++j) { const size_t r = rowof(c + 1, 16 * tq + j); f[j] = Fp[r * HGW + colq]; qv[j] = QHG[r * HGW + colq]; }
            vv = *(const u32x2*)(VHG + rowof(c + 1, vt) * HGW + colv); }
        asm volatile("s_waitcnt lgkmcnt(0)" ::: "memory"); __builtin_amdgcn_s_barrier(); asm volatile("" ::: "memory");
        f32x16 oacc = {};
        if (wid < 3) { const int sb = wid == 2 ? 1 : 0, tb = wid == 0 ? 0 : 1; f32x16 a = {};
#pragma unroll
            for (int st = 0; st < 8; ++st) { const bf16x8 av = *(const LAS bf16x8*)(L + OFF_KD + SW256(32 * sb + r32, (16 * st + 8 * hi) * 2)), bv = *(const LAS bf16x8*)(L + OFF_QG + SW256(32 * tb + r32, (16 * st + 8 * hi) * 2));
                a = __builtin_amdgcn_mfma_f32_32x32x16_bf16(av, bv, a, 0, 0, 0); }
            const int t = 32 * tb + r32;
#pragma unroll
            for (int q4 = 0; q4 < 4; ++q4) { const int sb0 = 32 * sb + 8 * q4 + 4 * hi; float x[4];
#pragma unroll
                for (int e = 0; e < 4; ++e) x[e] = (sb0 + e <= t) ? a[4 * q4 + e] : 0.f;
                u32x2 w; w.x = cvt_pk_bf16(x[0], x[1]); w.y = cvt_pk_bf16(x[2], x[3]);
                *(LAS u32x2*)(L + OFF_A + SW128(t, 2 * sb0)) = w; } }
        else if (wid == 4 || wid == 5) { const int tb = wid - 4;
#pragma unroll
            for (int st = 0; st < 8; ++st) { const bf16x8 av = *(const LAS bf16x8*)(L + OFF_QG + SW256(32 * tb + r32, (16 * st + 8 * hi) * 2)), bv = *(const LAS bf16x8*)(L + OFF_ST + SW256(r32, (16 * st + 8 * hi) * 2));
                oacc = __builtin_amdgcn_mfma_f32_32x32x16_bf16(av, bv, oacc, 0, 0, 0); } }
        asm volatile("s_waitcnt lgkmcnt(0)" ::: "memory"); __builtin_amdgcn_s_barrier(); asm volatile("" ::: "memory");
        if (wid == 4 || wid == 5) { const int tb = wid - 4;
#pragma unroll
            for (int st = 0; st < 4; ++st) { if (st < 2 * (tb + 1)) { const bf16x8 av = *(const LAS bf16x8*)(L + OFF_A + SW128(32 * tb + r32, (16 * st + 8 * hi) * 2)), bv = *(const LAS bf16x8*)(L + OFF_VT + SW128(r32, (16 * st + 8 * hi) * 2));
                oacc = __builtin_amdgcn_mfma_f32_32x32x16_bf16(av, bv, oacc, 0, 0, 0); } }
#pragma unroll
            for (int i = 0; i < 16; ++i) { const int tl = 32 * tb + (i & 3) + 8 * (i >> 2) + 4 * hi; O[rowof(c, tl) * HGW + h * 128 + vsl * 32 + r32] = oacc[i]; } }
        else if (wid < 4) {
#pragma unroll
            for (int q4 = 0; q4 < 4; ++q4) { const f32x4 d = *(const LAS f32x4*)(L + OFF_DL + (32 * wid + 8 * q4 + 4 * hi) * 4);
#pragma unroll
                for (int e = 0; e < 4; ++e) Sacc[4 * q4 + e] *= d[e]; }
#pragma unroll
            for (int st = 0; st < 4; ++st) { const bf16x8 av = *(const LAS bf16x8*)(L + OFF_KLT + SW128(32 * wid + r32, (16 * st + 8 * hi) * 2)), bv = *(const LAS bf16x8*)(L + OFF_VT + SW128(r32, (16 * st + 8 * hi) * 2));
                Sacc = __builtin_amdgcn_mfma_f32_32x32x16_bf16(av, bv, Sacc, 0, 0, 0); } }
    }
    asm volatile("s_waitcnt lgkmcnt(0)" ::: "memory"); __builtin_amdgcn_s_barrier(); asm volatile("" ::: "memory");
}
#undef SW256
#undef SW128
}

__device__ __forceinline__ void p_hgrn_combine(Frame& F) {
    const float* OF = F.out; const float* OB = F.out + (size_t)M * HGW; const bf16_t* GATE = wsp<bf16_t>(F, WS_GATE); bf16_t* MIXA = wsp<bf16_t>(F, WS_MIXA);
    const float* g = F.in[I_HGG];
    const int gw = F.bid * 8 + F.wave, NGW = F.G * 8;
    for (int m = gw; m < M; m += NGW) {
        const size_t base = (size_t)m * HGW + F.lane * 8;
        const f32x4 a0 = *(const f32x4*)(OF + base), a1 = *(const f32x4*)(OF + base + 4), b0 = *(const f32x4*)(OB + base), b1 = *(const f32x4*)(OB + base + 4);
        const f32x4 o0 = a0 + b0, o1 = a1 + b1;
        float ss = (o0[0] * o0[0] + o0[1] * o0[1]) + (o0[2] * o0[2] + o0[3] * o0[3]) + (o1[0] * o1[0] + o1[1] * o1[1]) + (o1[2] * o1[2] + o1[3] * o1[3]);
        ss += __shfl_xor(ss, 1); ss += __shfl_xor(ss, 2); ss += __shfl_xor(ss, 4); ss += __shfl_xor(ss, 8);
        const float rs = 1.0f / sqrtf(ss * (1.0f / 128.0f) + EPS);
        const int gc = (F.lane & 15) * 8; const f32x4 g0 = *(const f32x4*)(g + gc), g1 = *(const f32x4*)(g + gc + 4);
        const bf16x8 gt = *(const bf16x8*)(GATE + base);
        f32x4 y0, y1;
#pragma unroll
        for (int j = 0; j < 4; ++j) { y0[j] = o0[j] * rs * g0[j] * bf2f((bf16_t)gt[j]); y1[j] = o1[j] * rs * g1[j] * bf2f((bf16_t)gt[4 + j]); }
        u32x4 w; w.x = cvt_pk_bf16(y0[0], y0[1]); w.y = cvt_pk_bf16(y0[2], y0[3]); w.z = cvt_pk_bf16(y1[0], y1[1]); w.w = cvt_pk_bf16(y1[2], y1[3]);
        *(u32x4*)(MIXA + (size_t)m * DM + F.lane * 8) = w;
    }
}

__device__ __forceinline__ void p_ln_pass(Frame& F, const float* Y, const float* g, const float* bb, float* dst, bf16_t* dstb) {
    const int gw = F.bid * 8 + F.wave, NGW = F.G * 8;
    for (int m = gw; m < M; m += NGW) {
        const f32x4* xr = (const f32x4*)(Y + (size_t)m * DM) + F.lane;
        f32x4 v[4]; float s = 0.f;
#pragma unroll
        for (int j = 0; j < 4; ++j) { v[j] = xr[64 * j]; s += (v[j][0] + v[j][1]) + (v[j][2] + v[j][3]); }
        const float mean = wave_sum(s) * (1.f / DM); float s2 = 0.f;
#pragma unroll
        for (int j = 0; j < 4; ++j) { const f32x4 d = v[j] - mean; s2 += (d[0] * d[0] + d[1] * d[1]) + (d[2] * d[2] + d[3] * d[3]); }
        const float rstd = 1.f / sqrtf(wave_sum(s2) * (1.f / DM) + EPS);
#pragma unroll
        for (int j = 0; j < 4; ++j) { const int c = 4 * F.lane + 256 * j; const f32x4 gg = *(const f32x4*)(g + c), bv = *(const f32x4*)(bb + c);
            const f32x4 o = (v[j] - mean) * rstd * gg + bv; *(f32x4*)(dst + (size_t)m * DM + c) = o; if (dstb) st_bf16x4(dstb + (size_t)m * DM + c, o); }
    }
}

__device__ __forceinline__ void p_glu_naive(Frame& F, int hh) {
    const bf16_t* UH = wsp<bf16_t>(F, WS_UH); bf16_t* ACT = wsp<bf16_t>(F, WS_ACT); const float* CW = F.in[I_CW]; const float* CBv = F.in[I_CB];
    const int total = 8192 * (DFF / 8);
    for (int idx = F.bid * NTHREADS + F.tid; idx < total; idx += F.G * NTHREADS) {
        const int tl = idx / (DFF / 8), ch = (idx % (DFF / 8)) * 8; const int t = hh * 8192 + tl, pos = t % SEQ;
        const int pa = (ch >> 7) * 256 + (ch & 127), pb = pa + 128;
        const bool hp = pos > 0, hn = pos < SEQ - 1;
        bf16x8 z = {0, 0, 0, 0, 0, 0, 0, 0};
        const bf16x8 a0 = hp ? *(const bf16x8*)(UH + (size_t)(tl - 1) * NUP + pa) : z, a1 = *(const bf16x8*)(UH + (size_t)tl * NUP + pa), a2 = hn ? *(const bf16x8*)(UH + (size_t)(tl + 1) * NUP + pa) : z;
        const bf16x8 b0 = hp ? *(const bf16x8*)(UH + (size_t)(tl - 1) * NUP + pb) : z, b1 = *(const bf16x8*)(UH + (size_t)tl * NUP + pb), b2 = hn ? *(const bf16x8*)(UH + (size_t)(tl + 1) * NUP + pb) : z;
        float y[8];
#pragma unroll
        for (int j = 0; j < 8; ++j) { const int c = ch + j;
            const float ca = CW[c] * bf2f((bf16_t)a0[j]) + CW[NUP + c] * bf2f((bf16_t)a1[j]) + CW[2 * NUP + c] * bf2f((bf16_t)a2[j]) + CBv[c];
            const float cb = CW[DFF + c] * bf2f((bf16_t)b0[j]) + CW[NUP + DFF + c] * bf2f((bf16_t)b1[j]) + CW[2 * NUP + DFF + c] * bf2f((bf16_t)b2[j]) + CBv[DFF + c];
            y[j] = gelu_tanh(ca) * cb; }
        u32x4 w; w.x = cvt_pk_bf16(y[0], y[1]); w.y = cvt_pk_bf16(y[2], y[3]); w.z = cvt_pk_bf16(y[4], y[5]); w.w = cvt_pk_bf16(y[6], y[7]);
        *(u32x4*)(ACT + (size_t)t * DFF + ch) = w;
    }
}

__device__ __forceinline__ void down_fixup(Frame& F, int pm) {
    const float* HALO = wsp<float>(F, WS_HALO); bf16_t* ACT = wsp<bf16_t>(F, WS_ACT); const float* CW = F.in[I_CW]; const float* CBv = F.in[I_CB];
    for (int idx = F.tid; idx < 2 * DFF; idx += NTHREADS) {
        const int which = idx / DFF, ch = idx % DFF;
        const float* P; const float* C; const float* N;
        if (which == 0) { P = (pm % 8 == 0) ? nullptr : HALO + ((size_t)(pm - 1) * 4 + 3) * NUP; C = HALO + ((size_t)pm * 4 + 0) * NUP; N = HALO + ((size_t)pm * 4 + 1) * NUP; }
        else { P = HALO + ((size_t)pm * 4 + 2) * NUP; C = HALO + ((size_t)pm * 4 + 3) * NUP; N = (pm % 8 == 7) ? nullptr : HALO + ((size_t)(pm + 1) * 4 + 0) * NUP; }
        const float pa = P ? P[ch] : 0.f, pb = P ? P[DFF + ch] : 0.f, na = N ? N[ch] : 0.f, nb = N ? N[DFF + ch] : 0.f;
        const float ca = CW[ch] * pa + CW[NUP + ch] * C[ch] + CW[2 * NUP + ch] * na + CBv[ch];
        const float cb = CW[DFF + ch] * pb + CW[NUP + DFF + ch] * C[DFF + ch] + CW[2 * NUP + DFF + ch] * nb + CBv[DFF + ch];
        const float y = gelu_tanh(ca) * cb;
        ACT[(size_t)(pm * 256 + (which ? 255 : 0)) * DFF + ch] = (bf16_t)(cvt_pk_bf16(y, 0.f) & 0xffffu);
    }
    asm volatile("s_waitcnt vmcnt(0)" ::: "memory");
    __syncthreads();
}


namespace att {
constexpr int NW = 8, QBLK = 32, KVBLK = 64;
constexpr int SHM_V = KVBLK * 128 * 2, SHM_KN = KVBLK * 128 * 2, SHM_KR = KVBLK * 64 * 2;
constexpr int OFF_V = 0, OFF_KN = 2 * SHM_V, OFF_KR = OFF_KN + 2 * SHM_KN, OFF_WS = OFF_KR + 2 * SHM_KR, OFF_QR = OFF_WS + NW * 64 * 4, SHM_ATTN = OFF_QR + NW * 4096;
static_assert(SHM_ATTN <= RING_BYTES, "attention LDS");
#ifndef ATT_SDEPTH
#define ATT_SDEPTH 1
#endif
constexpr int SDEPTH = ATT_SDEPTH;
constexpr float THR = 8.f;
#define KSWZ(row, colB) ((row) * 256 + ((colB) ^ (((row) & 7) << 4)))
#define KRSWZ(row, colB) ((row) * 128 + ((colB) ^ (((row) & 7) << 4)))
#define SBAR() __builtin_amdgcn_sched_barrier(0)
__device__ __forceinline__ int crow(int r, int hi) { return (r & 3) + 8 * (r >> 2) + 4 * hi; }
__device__ __forceinline__ unsigned cvtpk(float lo, float hi) { unsigned r; asm volatile("v_cvt_pk_bf16_f32 %0, %1, %2" : "=v"(r) : "v"(lo), "v"(hi)); return r; }

__device__ __forceinline__ void partialSM(f32x16& p0, f32x16& p1, float& m_reg, float& mn, float& alpha) {
  constexpr float C = ATT_SCALE * 1.4426950408889634f;
  float pmax = p0[0];
#pragma unroll
  for (int r = 1; r < 16; ++r) pmax = fmaxf(pmax, p0[r]);
#pragma unroll
  for (int r = 0; r < 16; ++r) pmax = fmaxf(pmax, p1[r]);
  { auto rr = __builtin_amdgcn_permlane32_swap(__float_as_uint(pmax), __float_as_uint(pmax), false, false);
    pmax = fmaxf(__uint_as_float(rr[0]), __uint_as_float(rr[1])); }
  if (__builtin_expect(__all(pmax - m_reg <= THR / ATT_SCALE), 1)) { mn = m_reg; alpha = 1.f; }
  else { mn = fmaxf(m_reg, pmax); alpha = __builtin_amdgcn_exp2f((m_reg - mn) * C); m_reg = mn; }
  float mnC = -mn * C;
#pragma unroll
  for (int r = 0; r < 16; ++r) p0[r] = fmaf(p0[r], C, mnC);
#pragma unroll
  for (int r = 0; r < 16; ++r) p1[r] = fmaf(p1[r], C, mnC);
#pragma unroll
  for (int r = 0; r < 16; ++r) p0[r] = __builtin_amdgcn_exp2f(p0[r]);
}
__device__ __forceinline__ void finishSM(f32x16& p0, f32x16& p1, float alpha, float& l_reg, bf16x8& pa0, bf16x8& pa1, bf16x8& pa2, bf16x8& pa3) {
#pragma unroll
  for (int r = 0; r < 16; ++r) p1[r] = __builtin_amdgcn_exp2f(p1[r]);
  float ps = 0;
#pragma unroll
  for (int r = 0; r < 16; ++r) ps += p0[r];
#pragma unroll
  for (int r = 0; r < 16; ++r) ps += p1[r];
  { auto rr = __builtin_amdgcn_permlane32_swap(__float_as_uint(ps), __float_as_uint(ps), false, false);
    ps = __uint_as_float(rr[0]) + __uint_as_float(rr[1]); }
  l_reg = l_reg * alpha + ps;
#define PK4(P, BASE, OUT) do { unsigned a0 = cvtpk(P[BASE + 0], P[BASE + 1]), a1 = cvtpk(P[BASE + 2], P[BASE + 3]);   \
    unsigned b0 = cvtpk(P[BASE + 4], P[BASE + 5]), b1 = cvtpk(P[BASE + 6], P[BASE + 7]);                              \
    auto r0 = __builtin_amdgcn_permlane32_swap(a0, b0, false, false); auto r1 = __builtin_amdgcn_permlane32_swap(a1, b1, false, false); \
    u32x4 w = {r0[0], r1[0], r0[1], r1[1]}; OUT = *reinterpret_cast<bf16x8*>(&w); } while (0)
  PK4(p0, 0, pa0); PK4(p0, 8, pa1); PK4(p1, 0, pa2); PK4(p1, 8, pa3);
#undef PK4
}
__device__ __forceinline__ void qkt(f32x16& p0, f32x16& p1, const char* Kn, const char* Kr, const bf16x8* qr, const char* qpark, int r32, int hi) {
  p0 = f32x16{}; p1 = f32x16{};
#pragma unroll
  for (int d0 = 0; d0 < 8; ++d0) { int cb = (d0 * 16 + hi * 8) * 2;
    bf16x8 b0 = *reinterpret_cast<const bf16x8*>(Kn + KSWZ(r32, cb));
    bf16x8 b1 = *reinterpret_cast<const bf16x8*>(Kn + KSWZ(32 + r32, cb));
    p0 = __builtin_amdgcn_mfma_f32_32x32x16_bf16(b0, qr[d0], p0, 0, 0, 0);
    p1 = __builtin_amdgcn_mfma_f32_32x32x16_bf16(b1, qr[d0], p1, 0, 0, 0); }
#pragma unroll
  for (int d0 = 0; d0 < 4; ++d0) { int cb = (d0 * 16 + hi * 8) * 2;
    bf16x8 b0 = *reinterpret_cast<const bf16x8*>(Kr + KRSWZ(r32, cb));
    bf16x8 b1 = *reinterpret_cast<const bf16x8*>(Kr + KRSWZ(32 + r32, cb));
    const bf16x8 qv = *reinterpret_cast<const bf16x8*>(qpark + d0 * 1024);
    p0 = __builtin_amdgcn_mfma_f32_32x32x16_bf16(b0, qv, p0, 0, 0, 0);
    p1 = __builtin_amdgcn_mfma_f32_32x32x16_bf16(b1, qv, p1, 0, 0, 0); }
}
__device__ __forceinline__ int v_st(int k, int c) { const int kk = (k & ~0xC) | ((k & 4) << 1) | ((k & 8) >> 1); return ((kk >> 3) * 4 + (c >> 5)) * 512 + ((kk & 7) * 32 + (c & 31)) * 2; }
__device__ __forceinline__ int v_rd_base(int lane) { return ((lane & 3) << 3) | (((lane >> 2) & 3) << 6) | (((lane >> 4) & 1) << 5) | (((lane >> 5) & 1) << 8); }
constexpr int v_rd_off(int d0, int ks, int half) { return d0 * 512 + ks * 4096 + half * 2048; }
template <int OFF> __device__ __forceinline__ s16x4 tr_read(int vb) {
  s16x4 r; asm volatile("ds_read_b64_tr_b16 %0, %1 offset:%2" : "=&v"(r) : "v"(vb), "i"(OFF) : "memory"); return r;
}
template <int D0> __device__ __forceinline__ void pv_one(f32x16& od, int vb, bf16x8 pa0, bf16x8 pa1, bf16x8 pa2, bf16x8 pa3) {
  const s16x4 l0 = tr_read<v_rd_off(D0, 0, 0)>(vb), h0 = tr_read<v_rd_off(D0, 0, 1)>(vb), l1 = tr_read<v_rd_off(D0, 1, 0)>(vb), h1 = tr_read<v_rd_off(D0, 1, 1)>(vb);
  const s16x4 l2 = tr_read<v_rd_off(D0, 2, 0)>(vb), h2 = tr_read<v_rd_off(D0, 2, 1)>(vb), l3 = tr_read<v_rd_off(D0, 3, 0)>(vb), h3 = tr_read<v_rd_off(D0, 3, 1)>(vb);
  asm volatile("s_waitcnt lgkmcnt(0)" ::: "memory"); SBAR();
#define PK(L, H) (bf16x8){L[0], L[1], L[2], L[3], H[0], H[1], H[2], H[3]}
  od = __builtin_amdgcn_mfma_f32_32x32x16_bf16(pa0, PK(l0, h0), od, 0, 0, 0);
  od = __builtin_amdgcn_mfma_f32_32x32x16_bf16(pa1, PK(l1, h1), od, 0, 0, 0);
  od = __builtin_amdgcn_mfma_f32_32x32x16_bf16(pa2, PK(l2, h2), od, 0, 0, 0);
  od = __builtin_amdgcn_mfma_f32_32x32x16_bf16(pa3, PK(l3, h3), od, 0, 0, 0);
#undef PK
}
__device__ __forceinline__ void pv_d0(f32x16* o, int vb, bf16x8 pa0, bf16x8 pa1, bf16x8 pa2, bf16x8 pa3) {
  pv_one<0>(o[0], vb, pa0, pa1, pa2, pa3); pv_one<1>(o[1], vb, pa0, pa1, pa2, pa3); pv_one<2>(o[2], vb, pa0, pa1, pa2, pa3); pv_one<3>(o[3], vb, pa0, pa1, pa2, pa3);
}
constexpr int LDQ = NQ, LDK = NKV, LDKR = ROPE, LDO = DM;
__device__ __forceinline__ void attn_unit(const bf16_t* Qb, const bf16_t* Kn, const bf16_t* Vh, const bf16_t* Kr, bf16_t* Ob, const float* gn, int seq, char* lds, int tid) {
  const int wid = tid >> 6, lane = tid & 63, r32 = lane & 31, hi = lane >> 5;
  char* V_lds = lds + OFF_V; char* KN_lds = lds + OFF_KN; char* KR_lds = lds + OFF_KR;
  float* ws = (float*)(lds + OFF_WS) + wid * 64; float* li_l = ws; float* al_l = ws + 32;
  float m_reg = -1e30f, l_reg = 0; f32x16 o[4] = {}; bf16x8 qr[8];
  char* qpark = lds + OFF_QR + wid * 4096 + lane * 16;
  const bf16_t* Qw = Qb + (long)(wid * QBLK + r32) * LDQ + hi * 8;
#pragma unroll
  for (int d0 = 0; d0 < 8; ++d0) qr[d0] = *reinterpret_cast<const bf16x8*>(Qw + d0 * 16);
#pragma unroll
  for (int d0 = 0; d0 < 4; ++d0) *reinterpret_cast<bf16x8*>(qpark + d0 * 1024) = *reinterpret_cast<const bf16x8*>(Qw + 128 + d0 * 16);
  const int sr = tid >> 4, sc = (tid & 15) * 8, vst0 = v_st(sr, sc), vst1 = v_st(32 + sr, sc);
  const int krr = tid >> 3, krc = (tid & 7) * 8;
  const int vb0 = (int)(uintptr_t)V_lds + v_rd_base(lane);
  struct { bf16x8 vs0, vs1, ks0, ks1, kr; } sr_[SDEPTH];
#define SLOAD(i, k0) do { sr_[i].vs0 = *(const bf16x8*)(&Vh[(long)((k0) + sr) * LDK + sc]); sr_[i].vs1 = *(const bf16x8*)(&Vh[(long)((k0) + 32 + sr) * LDK + sc]); \
    sr_[i].ks0 = *(const bf16x8*)(&Kn[(long)((k0) + sr) * LDK + sc]); sr_[i].ks1 = *(const bf16x8*)(&Kn[(long)((k0) + 32 + sr) * LDK + sc]); \
    sr_[i].kr = *(const bf16x8*)(&Kr[(long)((k0) + krr) * LDKR + krc]); } while (0)
#define SWRITE(b, i) do { *(bf16x8*)(V_lds + (b) * SHM_V + vst0) = sr_[i].vs0; *(bf16x8*)(V_lds + (b) * SHM_V + vst1) = sr_[i].vs1; int kc = sc * 2;               \
    *(bf16x8*)(KN_lds + (b) * SHM_KN + KSWZ(sr, kc)) = sr_[i].ks0; *(bf16x8*)(KN_lds + (b) * SHM_KN + KSWZ(32 + sr, kc)) = sr_[i].ks1; \
    *(bf16x8*)(KR_lds + (b) * SHM_KR + KRSWZ(krr, krc * 2)) = sr_[i].kr; } while (0)
#define SWAIT() do { if constexpr (SDEPTH == 2) asm volatile("s_waitcnt vmcnt(5)" ::: "memory"); else asm volatile("s_waitcnt vmcnt(0)" ::: "memory"); } while (0)
#define RESC(a) do { if (__any((a) < 1.f)) { if (hi == 0) al_l[r32] = (a); asm volatile("s_waitcnt lgkmcnt(0)" ::: "memory"); \
    _Pragma("unroll") for (int d = 0; d < 4; ++d) _Pragma("unroll") for (int r = 0; r < 16; ++r) o[d][r] *= al_l[crow(r, hi)]; } } while (0)
  f32x16 p0, p1; float mn, al; bf16x8 pa0, pa1, pa2, pa3; const int NT = seq / KVBLK;
  SLOAD(0, 0); asm volatile("s_waitcnt vmcnt(0)" ::: "memory"); SWRITE(0, 0); __syncthreads();
  for (int j = 0; j < NT; ++j) {
    const int b = j & 1;
    SBAR(); qkt(p0, p1, KN_lds + b * SHM_KN, KR_lds + b * SHM_KR, qr, qpark, r32, hi);
    partialSM(p0, p1, m_reg, mn, al);
    RESC(al);
    finishSM(p0, p1, al, l_reg, pa0, pa1, pa2, pa3); SBAR();
    if (j + 1 < NT) SLOAD(0, (j + 1) * KVBLK);
    SBAR();
    pv_d0(o, vb0 + b * (int)SHM_V, pa0, pa1, pa2, pa3);
    if (j + 1 < NT) { asm volatile("s_waitcnt vmcnt(0)" ::: "memory"); SWRITE(b ^ 1, 0); }
    __syncthreads();
  }
  if (hi == 0) li_l[r32] = l_reg; asm volatile("s_waitcnt lgkmcnt(0)" ::: "memory");
  bf16_t* Ow = Ob + (long)(wid * QBLK) * LDO;
  float g4[4];
#pragma unroll
  for (int d0 = 0; d0 < 4; ++d0) g4[d0] = gn[d0 * 32 + r32];
#pragma unroll
  for (int r = 0; r < 16; ++r) { const int orow = crow(r, hi); const float rl = __builtin_amdgcn_rcpf(li_l[orow]);
    float v[4], ss = 0.f;
#pragma unroll
    for (int d0 = 0; d0 < 4; ++d0) { v[d0] = o[d0][r] * rl; ss += v[d0] * v[d0]; }
    ss += __shfl_xor(ss, 1); ss += __shfl_xor(ss, 2); ss += __shfl_xor(ss, 4); ss += __shfl_xor(ss, 8); ss += __shfl_xor(ss, 16);
    const float rs = 1.0f / sqrtf(ss * (1.0f / 128.0f) + EPS);
#pragma unroll
    for (int d0 = 0; d0 < 4; ++d0) Ow[(long)orow * LDO + d0 * 32 + r32] = (bf16_t)(cvtpk(v[d0] * rs * g4[d0], 0.f) & 0xffffu); }
  __syncthreads();
#undef SLOAD
#undef SWRITE
#undef SWAIT
#undef RESC
}
#undef KSWZ
#undef KRSWZ
#undef SBAR
}

#define XB_TMO      128
#define XB_XCNT(j)  (256  + 64 * (j))
#define XB_XSUB(j)  (1280 + 64 * (j))
#define XB_XGEN(j)  (2304 + 64 * (j))
#define XB_TOP      3328
#define XB_TOPGEN   3392
#define XCD_BAR_WORDS 3456
#define XB_SPIN_CAP (1u << 18)
__device__ __forceinline__ unsigned xb_ld(unsigned* p)              { return __hip_atomic_load(p, __ATOMIC_RELAXED, __HIP_MEMORY_SCOPE_AGENT); }
__device__ __forceinline__ unsigned xb_add(unsigned* p, unsigned v) { return __hip_atomic_fetch_add(p, v, __ATOMIC_RELAXED, __HIP_MEMORY_SCOPE_AGENT); }
__device__ __forceinline__ unsigned xb_xcc_id() { return (unsigned)__builtin_amdgcn_s_getreg((3 << 11) | 20) & 0xFu; }
#define XB_SPIN(cond, bar) do { unsigned _sp = 0; while (cond) { __builtin_amdgcn_s_sleep(1); \
    if ((++_sp & 255u) == 0u) { if (xb_ld(&(bar)[XB_TMO])) break; if (_sp > XB_SPIN_CAP) { atomicAdd(&(bar)[XB_TMO], 1u); break; } } } } while (0)
struct XcdBarrier { unsigned* bar; unsigned x; volatile LAS unsigned* st; };
__device__ __forceinline__ XcdBarrier xcd_barrier_post(unsigned* bar, volatile LAS unsigned* st, int tid) {
    XcdBarrier b; b.bar = bar; b.x = xb_xcc_id(); b.st = st;
    if (tid == 0) (void)xb_add(&bar[XB_XCNT(b.x)], 1u);
    return b;
}
__device__ __forceinline__ void xcd_barrier_complete(unsigned* bar, unsigned x, unsigned G, unsigned& nloc, unsigned& nx) {
    unsigned sum, cnt, mine, sp = 0u;
    for (;;) {
        sum = 0u; cnt = 0u; mine = 0u;
#pragma unroll
        for (unsigned j = 0; j < 16; ++j) { const unsigned c = xb_ld(&bar[XB_XCNT(j)]); sum += c; cnt += (c > 0u) ? 1u : 0u; mine = (j == x) ? c : mine; }
        if (sum == G) break;
        __builtin_amdgcn_s_sleep(1);
        if ((++sp & 255u) == 0u) { if (xb_ld(&bar[XB_TMO])) break; if (sp > XB_SPIN_CAP) { atomicAdd(&bar[XB_TMO], 1u); break; } }
    }
    nloc = mine > 0u ? mine : 1u; nx = cnt > 0u ? cnt : 1u;
}
__device__ __forceinline__ void xcd_barrier(const XcdBarrier& b, int tid, unsigned G) {
    asm volatile("s_waitcnt vmcnt(0)" ::: "memory");
    __syncthreads();
    if (tid == 0) {
        unsigned* bar = b.bar;
        __builtin_amdgcn_s_waitcnt(0);
        unsigned nloc = b.st[0], nx = b.st[1];
        if (nloc == 0u) { xcd_barrier_complete(bar, b.x, G, nloc, nx); b.st[0] = nloc; b.st[1] = nx; }
        const unsigned old = xb_add(&bar[XB_XSUB(b.x)], 1u);
        const unsigned gen = old / nloc;
        if (old + 1u == (gen + 1u) * nloc) {
            __builtin_amdgcn_fence(__ATOMIC_RELEASE, "agent");
            asm volatile("s_waitcnt vmcnt(0)" ::: "memory");
            const unsigned og = xb_add(&bar[XB_TOP], 1u);
            const unsigned tg = og / nx;
            if (og + 1u == (tg + 1u) * nx) xb_add(&bar[XB_TOPGEN], 1u);
            else XB_SPIN(xb_ld(&bar[XB_TOPGEN]) == tg, bar);
            __builtin_amdgcn_fence(__ATOMIC_ACQUIRE, "agent");
            xb_add(&bar[XB_XGEN(b.x)], 1u);
            asm volatile("s_waitcnt vmcnt(0)" ::: "memory");
        } else {
            XB_SPIN(xb_ld(&bar[XB_XGEN(b.x)]) == gen, bar);
            __builtin_amdgcn_fence(__ATOMIC_ACQUIRE, "agent");
            asm volatile("s_waitcnt vmcnt(0)" ::: "memory");
        }
    }
    __syncthreads();
}

constexpr int PH_PRO = 0, PH_INPROJ = 1, PH_SSQ = 2, PH_QKV = 3, PH_ATT = 4, PH_SCAN = 5, PH_COMB = 6, PH_OUT = 7, PH_LN1 = 8, PH_UP = 9, PH_GLU0 = 10, PH_UP1 = 11, PH_GLU1 = 12, PH_FIX = 13, PH_DOWN = 14, PH_LN2 = 15, PH_N = 16;

#ifndef MK_PHMASK
#define MK_PHMASK 0xFFFFFFFFu
#endif
__host__ __device__ constexpr bool phase_on(int ph) {
    return !((ph == PH_SSQ && !(NAIVE & NV_IN)) || ((ph == PH_GLU0 || ph == PH_UP1 || ph == PH_GLU1) && !(NAIVE & NV_UP)) || (ph == PH_FIX && !(!(NAIVE & NV_UP) && (NAIVE & NV_DOWN))));
}
template <int ph> __device__ __forceinline__ void run_phase(const Frame& F0) {
    using namespace pg8;
    if (!((MK_PHMASK >> ph) & 1u)) return;
    Frame F = F0; { int l = (int)__builtin_amdgcn_mbcnt_hi(~0u, __builtin_amdgcn_mbcnt_lo(~0u, 0u)); asm volatile("" : "+v"(l)); F.lane = l; F.tid = F0.wave * 64 + l; }
    if constexpr (ph == PH_PRO) { p0_prologue(F); }
    else if constexpr (ph == PH_INPROJ) {
        QInProj q{wsp<bf16_t>(F, WS_QHG), wsp<bf16_t>(F, WS_VHG), wsp<bf16_t>(F, WS_GATE), wsp<bf16_t>(F, WS_QA), wsp<bf16_t>(F, WS_KVA), wsp<bf16_t>(F, WS_KPE),
                  wsp<float>(F, WS_FF), wsp<float>(F, WS_FB), wsp<float>(F, WS_LBF), wsp<float>(F, WS_LBB), wsp<float>(F, WS_COS), wsp<float>(F, WS_SIN)};
        if (NAIVE & NV_IN) naive_gemm(F.lds, F.tid, wsp<bf16_t>(F, WS_XN), DM, wsp<bf16_t>(F, WS_WIN), DM, 0, M, INCP, DM, q);
        else { Gemm g{wsp<bf16_t>(F, WS_XN), wsp<bf16_t>(F, WS_WIN), M, INCP, DM}; StaticOrder<M, INCP> S; S.init(F.G, F.bid);
               EpiInProj E{q, wsp<float>(F, WS_SSQQ), wsp<float>(F, WS_SSQKV)}; gemm_phase<DM, EpiInProj, StaticOrder<M, INCP>, true, true>(F.lds, F.tid, g, S, E); }
    }
    else if constexpr (ph == PH_SSQ) { if (NAIVE & NV_IN) p_ssq_naive(F); }
    else if constexpr (ph == PH_QKV) {
        QQb qq{wsp<bf16_t>(F, WS_QAT), wsp<float>(F, WS_SSQQ), wsp<float>(F, WS_COS), wsp<float>(F, WS_SIN)};
        QKvb qk{wsp<bf16_t>(F, WS_KV), wsp<float>(F, WS_SSQKV)};
        if (NAIVE & NV_QKV) { naive_gemm(F.lds, F.tid, wsp<bf16_t>(F, WS_QA), QRANK, wsp<bf16_t>(F, WS_WQB), QRANK, 0, M, NQ, QRANK, qq);
                              naive_gemm(F.lds, F.tid, wsp<bf16_t>(F, WS_KVA), KVRANK, wsp<bf16_t>(F, WS_WKVB), KVRANK, 0, M, NKV, KVRANK, qk); }
        else {
#ifndef SKIP_QB
 { Gemm g{wsp<bf16_t>(F, WS_QA), wsp<bf16_t>(F, WS_WQB), M, NQ, QRANK}; StaticOrder<M, NQ> S; S.init(F.G, F.bid); EpiQuad<QQb> E{qq}; gemm_phase<QRANK, EpiQuad<QQb>, StaticOrder<M, NQ>, true, true>(F.lds, F.tid, g, S, E); }
#endif
#ifndef SKIP_KVB
               { Gemm g{wsp<bf16_t>(F, WS_KVA), wsp<bf16_t>(F, WS_WKVB), M, NKV, KVRANK}; StaticOrder<M, NKV> S; S.init(F.G, F.bid); EpiQuad<QKvb> E{qk}; gemm_phase<KVRANK, EpiQuad<QKvb>, StaticOrder<M, NKV>, true, true>(F.lds, F.tid, g, S, E); }
#endif
 }
    }
    else if constexpr (ph == PH_ATT) {
        if (NAIVE & NV_ATT) p_attn_naive(F);
        else { const bf16_t* QAT = wsp<bf16_t>(F, WS_QAT); const bf16_t* KV = wsp<bf16_t>(F, WS_KV); const bf16_t* KPE = wsp<bf16_t>(F, WS_KPE); bf16_t* MIXA = wsp<bf16_t>(F, WS_MIXA);
            for (int u = F.vcu; u < 256; u += F.G) { const int bh = u >> 3, qb = u & 7, b = bh >> 2, h = bh & 3; const size_t row0 = (size_t)b * SEQ + qb * 256, k0 = (size_t)b * SEQ;
                att::attn_unit(QAT + row0 * NQ + h * 192, KV + k0 * NKV + h * 256, KV + k0 * NKV + h * 256 + 128, KPE + k0 * ROPE, MIXA + row0 * DM + 512 + h * 128, F.in[I_ATG], SEQ, (char*)F.lds, F.tid); } }
    }
    else if constexpr (ph == PH_SCAN) {
#if MK_HG_DIRECT
        p_hgrn_scan(F);
#else
        for (int item = F.vcu; item < 256; item += F.G) hg::scan_item(F, item);
#endif
    }
    else if constexpr (ph == PH_COMB) { p_hgrn_combine(F); }
    else if constexpr (ph == PH_OUT) {
        QOut q{wsp<float>(F, WS_Y), F.in[I_X], wsp<float>(F, WS_MU0), wsp<float>(F, WS_RS0), F.in[I_LNG], F.in[I_LNB]};
        if (NAIVE & NV_OUT) naive_gemm(F.lds, F.tid, wsp<bf16_t>(F, WS_MIXA), DM, wsp<bf16_t>(F, WS_WOUT), DM, 0, M, DM, DM, q);
        else { Gemm g{wsp<bf16_t>(F, WS_MIXA), wsp<bf16_t>(F, WS_WOUT), M, DM, DM}; StaticOrder<M, DM> S; S.init(F.G, F.bid); EpiQuad<QOut> E{q}; gemm_phase<DM, EpiQuad<QOut>, StaticOrder<M, DM>, true, true>(F.lds, F.tid, g, S, E); }
    }
    else if constexpr (ph == PH_LN1) { p_ln_pass(F, wsp<float>(F, WS_Y), F.in[I_L1G], F.in[I_L1B], F.out, wsp<bf16_t>(F, WS_H1B)); }
    else if constexpr (ph == PH_UP) {
        if (NAIVE & NV_UP) { QUpNaive q{wsp<bf16_t>(F, WS_UH), 0}; naive_gemm(F.lds, F.tid, wsp<bf16_t>(F, WS_H1B), DM, wsp<bf16_t>(F, WS_WUP), DM, 0, 8192, NUP, DM, q); }
        else { Gemm g{wsp<bf16_t>(F, WS_H1B), wsp<bf16_t>(F, WS_WUP), M, NUP, DM}; StaticOrder<M, NUP> S; S.init(F.G, F.bid);
               EpiConvGlu E{wsp<bf16_t>(F, WS_ACT), wsp<float>(F, WS_HALO), F.in[I_CW], F.in[I_CB], (LAS float*)(F.lds + LDS_BND)}; gemm_phase<DM, EpiConvGlu, StaticOrder<M, NUP>, true, true>(F.lds, F.tid, g, S, E); }
    }
    else if constexpr (ph == PH_GLU0) { if (NAIVE & NV_UP) p_glu_naive(F, 0); }
    else if constexpr (ph == PH_UP1) { if (NAIVE & NV_UP) { QUpNaive q{wsp<bf16_t>(F, WS_UH), 8192}; naive_gemm(F.lds, F.tid, wsp<bf16_t>(F, WS_H1B), DM, wsp<bf16_t>(F, WS_WUP), DM, 8192, 8192, NUP, DM, q); } }
    else if constexpr (ph == PH_GLU1) { if (NAIVE & NV_UP) p_glu_naive(F, 1); }
    else if constexpr (ph == PH_FIX) { if (!(NAIVE & NV_UP) && (NAIVE & NV_DOWN)) { for (int pm = F.bid; pm < 64; pm += F.G) down_fixup(F, pm); } }
    else if constexpr (ph == PH_DOWN) {
        QDown q{wsp<float>(F, WS_Y), F.out};
        if (NAIVE & NV_DOWN) {
            naive_gemm(F.lds, F.tid, wsp<bf16_t>(F, WS_ACT), DFF, wsp<bf16_t>(F, WS_WDN), DFF, 0, M, DM, DFF, q);
        } else { Gemm g{wsp<bf16_t>(F, WS_ACT), wsp<bf16_t>(F, WS_WDN), M, DM, DFF}; StaticOrder<M, DM> S; S.init(F.G, F.bid);
            if (!(NAIVE & NV_UP)) { Unit u; if (S.next(0, u)) down_fixup(F, u.pm); }
            EpiQuad<QDown> E{q}; gemm_phase<DFF, EpiQuad<QDown>, StaticOrder<M, DM>, true, true>(F.lds, F.tid, g, S, E); }
    }
    else if constexpr (ph == PH_LN2) { p_ln_pass(F, wsp<float>(F, WS_Y), F.in[I_L2G], F.in[I_L2B], F.out, nullptr); }
}

__global__ void __launch_bounds__(NTHREADS, 2) mk_fwd(Params p) {
    extern __shared__ __attribute__((aligned(16))) unsigned char lds_raw[];
    Frame F;
    F.lds = (LAS unsigned char*)lds_raw;
    F.tid = threadIdx.x; F.lane = F.tid & 63; F.wave = __builtin_amdgcn_readfirstlane(F.tid >> 6);
    LAS unsigned* MISC = (LAS unsigned*)(F.lds + LDS_MISC);
    if (F.tid < 32) MISC[F.tid] = 0u;
    __syncthreads();
    F.G = gridDim.x; F.bid = blockIdx.x; F.vcu = (F.G % 8 == 0) ? (F.bid % 8) * (F.G / 8) + F.bid / 8 : F.bid;
    F.in = p.in; F.out = p.out; F.ws = p.ws;
#if MK_ONE_LAUNCH
    XcdBarrier xbar = xcd_barrier_post((unsigned*)(p.ws + WS_CTL) + 1024, (volatile LAS unsigned*)(MISC + 8), F.tid);
#endif
#if MK_ONE_LAUNCH
#define GSYNC() do { const int l_ = (int)__builtin_amdgcn_mbcnt_hi(~0u, __builtin_amdgcn_mbcnt_lo(~0u, 0u)); xcd_barrier(xbar, F.wave * 64 + l_, (unsigned)F.G); } while (0)
#else
#define GSYNC() do { } while (0)
#endif
#define PHASE(k) do { if (phase_on(k) && p.ph_lo <= (k) && (k) < p.ph_hi) { run_phase<(k)>(F); if ((k) + 1 < p.ph_hi) GSYNC(); } } while (0)
    PHASE(0); PHASE(1); PHASE(2); PHASE(3); PHASE(4); PHASE(5); PHASE(6); PHASE(7); PHASE(8); PHASE(9); PHASE(10); PHASE(11); PHASE(12); PHASE(13); PHASE(14); PHASE(15);
    static_assert(PH_N == 16, "phase list");
}

extern "C" void kernel_launch(void* const* d_in, const int* in_sizes, int n_in, void* d_out, int out_size, void* d_ws, size_t ws_size, hipStream_t stream) {
    static int grid = 0;
    if (grid == 0) {
        if (n_in != 22 || in_sizes[0] != M * DM || out_size != M * DM || ws_size < WS_END) { fprintf(stderr, "kernel_launch: unexpected shapes (n_in %d, in0 %d, out %d, ws %zu)\n", n_in, n_in > 0 ? in_sizes[0] : -1, out_size, ws_size); grid = -1; return; }
        int dev = 0, cus = 0, per_cu = 0;
        (void)hipGetDevice(&dev); (void)hipDeviceGetAttribute(&cus, hipDeviceAttributeMultiprocessorCount, dev);
        if (hipFuncSetAttribute((const void*)mk_fwd, hipFuncAttributeMaxDynamicSharedMemorySize, LDS_BYTES) != hipSuccess) { fprintf(stderr, "kernel_launch: hipFuncSetAttribute failed\n"); grid = -1; return; }
        (void)hipOccupancyMaxActiveBlocksPerMultiprocessor(&per_cu, (const void*)mk_fwd, NTHREADS, LDS_BYTES);
        if (per_cu < 1) { fprintf(stderr, "kernel_launch: occupancy query says %d blocks per CU\n", per_cu); per_cu = 1; }
        (void)hipGetLastError();
        grid = cus;
    }
    if (grid < 0) return;
    Params p{};
    for (int i = 0; i < 22; ++i) p.in[i] = (const float*)d_in[i];
    p.out = (float*)d_out; p.ws = (unsigned char*)d_ws;
#if MK_ONE_LAUNCH
    p.ph_lo = 0; p.ph_hi = PH_N;
    if (hipMemsetAsync((char*)d_ws + WS_CTL, 0, 65536, stream) != hipSuccess) { fprintf(stderr, "kernel_launch: memset failed\n"); return; }
    void* args[] = {&p};
    hipError_t e = hipLaunchCooperativeKernel((const void*)mk_fwd, dim3(grid), dim3(NTHREADS), args, LDS_BYTES, stream);
    if (e != hipSuccess) fprintf(stderr, "cooperative launch failed: %s (grid %d)\n", hipGetErrorString(e), grid);
#else
    for (int ph = 0; ph < PH_N; ++ph) {
        if (!phase_on(ph)) continue;
        p.ph_lo = ph; p.ph_hi = ph + 1;
        hipLaunchKernelGGL(mk_fwd, dim3(grid), dim3(NTHREADS), LDS_BYTES, stream, p);
    }
#endif
}
```
